# Optimizing an MI355X kernel written in HIP

```python
import math
import jax, jax.numpy as jnp
from jax import lax
import numpy as np

D_MODEL = 1024
BATCH = 8
SEQ = 2048
DEPTH = 4
DEC_BATCH = 8
DEC_SEQ = 16
PAST_LEN = 4096

CHUNK = 64
N_A_LAYERS = DEPTH // 2
N_B_LAYERS = DEPTH - N_A_LAYERS
D_FF = 2816
SSM_GROUP = 16
N_GROUPS = D_MODEL // SSM_GROUP
SSM_STATE = 64
DT_MIN = 1e-3
DT_MAX = 1e-1
N_HEADS = 16
HEAD_DIM = D_MODEL // N_HEADS
N_LEFT_CHUNKS = 8
BAND_PAST = N_LEFT_CHUNKS * CHUNK
BAND = (N_LEFT_CHUNKS + 1) * CHUNK
MAX_REL = 128
N_REL = 2 * MAX_REL + 1
EPS = 1e-6
SCALE = HEAD_DIM ** -0.5
NEG_INF = -1e30

kernel_name = 'yoco_s5_chunkband_relbias_encoder_step'


def _rmsnorm(x, g):
    xf = x.astype(jnp.float32)
    y = xf * lax.rsqrt(jnp.mean(xf * xf, axis=-1, keepdims=True) + EPS)
    return (y * g.astype(jnp.float32)).astype(x.dtype)


def _swiglu(x, w_in, w_out):
    gate, up = jnp.split(x @ w_in, 2, axis=-1)
    return (jax.nn.silu(gate) * up) @ w_out


def _half_ffn(x, g_pre, g_post, w_in, w_out):
    return x + 0.5 * _rmsnorm(_swiglu(_rmsnorm(x, g_pre), w_in, w_out), g_post)


def _ssm_combine(e1, e2):
    a1, b1 = e1
    a2, b2 = e2
    return a1 * a2, a2 * b1 + b2


def _s5_mixer(u, h0_re, h0_im, lam_re, lam_im, log_step, b_re, b_im, c_re, c_im, d_skip, w_glu):
    f32 = jnp.float32
    n, l, _ = u.shape
    uf = u.astype(f32).reshape(n, l, N_GROUPS, SSM_GROUP)
    lam = lax.complex(lam_re.astype(f32), lam_im.astype(f32))
    step = jnp.exp(log_step.astype(f32))[:, None]
    a_bar = jnp.exp(lam * step)
    b_bar = ((a_bar - 1) / lam)[..., None] * lax.complex(b_re.astype(f32), b_im.astype(f32))
    bu = jnp.einsum('gpc,nlgc->nlgp', b_bar, uf.astype(jnp.complex64))
    h0 = lax.complex(h0_re.astype(f32), h0_im.astype(f32))
    bu = bu.at[:, 0].add(a_bar * h0)
    _, h = lax.associative_scan(_ssm_combine, (jnp.broadcast_to(a_bar, bu.shape), bu), axis=1)
    c = lax.complex(c_re.astype(f32), c_im.astype(f32))
    y = jnp.einsum('gcp,nlgp->nlgc', c, h).real + d_skip.astype(f32).reshape(N_GROUPS, SSM_GROUP) * uf
    y = jax.nn.gelu(y.reshape(n, l, D_MODEL))
    val, gate = jnp.split(y @ w_glu.astype(f32), 2, axis=-1)
    out = (val * jax.nn.sigmoid(gate)).astype(u.dtype)
    h_last = h[:, -1]
    return out, h_last.real.astype(h0_re.dtype), h_last.imag.astype(h0_im.dtype)


def _band_attention_prompt(xn, k, v, w_q, w_o, table):
    f32 = jnp.float32
    n, l, _ = xn.shape
    nc = l // CHUNK
    q = (xn @ w_q).astype(f32).reshape(n, nc, CHUNK, N_HEADS, HEAD_DIM)
    pad = ((0, 0), (BAND_PAST, 0), (0, 0), (0, 0))
    kp = jnp.pad(k, pad).reshape(n, nc + N_LEFT_CHUNKS, CHUNK, N_HEADS, HEAD_DIM)
    vp = jnp.pad(v, pad).reshape(n, nc + N_LEFT_CHUNKS, CHUNK, N_HEADS, HEAD_DIM)
    kb = jnp.concatenate([kp[:, o:o + nc] for o in range(N_LEFT_CHUNKS + 1)], axis=2)
    vb = jnp.concatenate([vp[:, o:o + nc] for o in range(N_LEFT_CHUNKS + 1)], axis=2)
    qi = jnp.arange(CHUNK)
    kj = jnp.arange(BAND)
    rel = jnp.clip(qi[:, None] + BAND_PAST - kj[None, :], -MAX_REL, MAX_REL) + MAX_REL
    bias = table.astype(f32)[:, rel]
    valid = (jnp.arange(nc)[:, None] - N_LEFT_CHUNKS + kj[None, :] // CHUNK) >= 0
    s = jnp.einsum('ncihd,ncjhd->nhcij', q, kb.astype(f32)) * SCALE + bias[:, None]
    s = jnp.where(valid[:, None, :], s, NEG_INF)
    p = jax.nn.softmax(s, axis=-1).astype(v.dtype)
    o = jnp.einsum('nhcij,ncjhd->ncihd', p, vb).reshape(n, l, D_MODEL)
    return o @ w_o


def _band_attention_sample(xn, k, v, q_pos, k_pos, w_q, w_o, table):
    f32 = jnp.float32
    n, s_len, _ = xn.shape
    q = (xn @ w_q).astype(f32).reshape(n, s_len, N_HEADS, HEAD_DIM)
    rel = jnp.clip(q_pos[:, None] - k_pos[None, :], -MAX_REL, MAX_REL) + MAX_REL
    bias = table.astype(f32)[:, rel]
    qc = q_pos // CHUNK
    kc = k_pos // CHUNK
    valid = (kc[None, :] <= qc[:, None]) & (kc[None, :] >= qc[:, None] - N_LEFT_CHUNKS)
    sc = jnp.einsum('nqhd,nkhd->nhqk', q, k.astype(f32)) * SCALE + bias
    sc = jnp.where(valid, sc, NEG_INF)
    p = jax.nn.softmax(sc, axis=-1).astype(v.dtype)
    o = jnp.einsum('nhqk,nkhd->nqhd', p, v).reshape(n, s_len, D_MODEL)
    return o @ w_o


def setup_inputs(seed: int = 0) -> dict:
    key = jax.random.key(seed)
    ks = jax.random.split(key, 24)
    f32 = jnp.float32
    D = D_MODEL

    def nrm(k, shape, scale):
        return scale * jax.random.normal(k, shape, f32)

    cache_rows = min(BAND_PAST, PAST_LEN)
    ssm_state_shape = (N_A_LAYERS, DEC_BATCH, N_GROUPS, SSM_STATE)
    return {
        'x_prompt': nrm(ks[0], (BATCH, SEQ, D), 1.0),
        'x_sample': nrm(ks[1], (DEC_BATCH, DEC_SEQ, D), 1.0),
        'state_ssm_re': nrm(ks[2], ssm_state_shape, 0.1),
        'state_ssm_im': nrm(ks[3], ssm_state_shape, 0.1),
        'cache_k': nrm(ks[4], (DEC_BATCH, cache_rows, N_HEADS, HEAD_DIM), 1.0),
        'cache_v': nrm(ks[5], (DEC_BATCH, cache_rows, N_HEADS, HEAD_DIM), 1.0),
        'norm_gains': 1.0 + nrm(ks[6], (DEPTH, 6, D), 0.05),
        'ffn1_w_in': nrm(ks[7], (DEPTH, D, 2 * D_FF), D ** -0.5),
        'ffn1_w_out': nrm(ks[8], (DEPTH, D_FF, D), D_FF ** -0.5),
        'ffn2_w_in': nrm(ks[9], (DEPTH, D, 2 * D_FF), D ** -0.5),
        'ffn2_w_out': nrm(ks[10], (DEPTH, D_FF, D), D_FF ** -0.5),
        'ssm_lambda_re': -0.5 * jnp.exp(nrm(ks[11], (N_A_LAYERS, N_GROUPS, SSM_STATE), 0.01)),
        'ssm_lambda_im': math.pi * jnp.broadcast_to(jnp.arange(SSM_STATE, dtype=f32), (N_A_LAYERS, N_GROUPS, SSM_STATE)),
        'ssm_log_step': jax.random.uniform(ks[12], (N_A_LAYERS, N_GROUPS), f32, math.log(DT_MIN), math.log(DT_MAX)),
        'ssm_b_re': nrm(ks[13], (N_A_LAYERS, N_GROUPS, SSM_STATE, SSM_GROUP), (2 * SSM_GROUP) ** -0.5),
        'ssm_b_im': nrm(ks[14], (N_A_LAYERS, N_GROUPS, SSM_STATE, SSM_GROUP), (2 * SSM_GROUP) ** -0.5),
        'ssm_c_re': nrm(ks[15], (N_A_LAYERS, N_GROUPS, SSM_GROUP, SSM_STATE), SSM_STATE ** -0.5),
        'ssm_c_im': nrm(ks[16], (N_A_LAYERS, N_GROUPS, SSM_GROUP, SSM_STATE), SSM_STATE ** -0.5),
        'ssm_d': nrm(ks[17], (N_A_LAYERS, D), 1.0),
        'ssm_w_glu': nrm(ks[18], (N_A_LAYERS, D, 2 * D), D ** -0.5),
        'kv_norm': 1.0 + nrm(ks[19], (D,), 0.05),
        'w_kv': nrm(ks[20], (D, 2 * D), D ** -0.5),
        'attn_w_q': nrm(ks[21], (N_B_LAYERS, D, D), D ** -0.5),
        'attn_w_o': nrm(ks[22], (N_B_LAYERS, D, D), D ** -0.5),
        'attn_rel_bias': nrm(ks[23], (N_B_LAYERS, N_HEADS, N_REL), 0.2),
    }


def reference(x_prompt, x_sample, state_ssm_re, state_ssm_im, cache_k, cache_v,
              norm_gains, ffn1_w_in, ffn1_w_out, ffn2_w_in, ffn2_w_out,
              ssm_lambda_re, ssm_lambda_im, ssm_log_step, ssm_b_re, ssm_b_im,
              ssm_c_re, ssm_c_im, ssm_d, ssm_w_glu,
              kv_norm, w_kv, attn_w_q, attn_w_o, attn_rel_bias):

    def trunk(x, h0_re, h0_im, past_k, past_v):
        n, l, _ = x.shape
        ssm_re, ssm_im = [], []
        k = v = None
        if past_k is not None:
            r = past_k.shape[1]
            q_pos = PAST_LEN + jnp.arange(l)
            k_pos = jnp.concatenate([PAST_LEN - r + jnp.arange(r), q_pos])
        for layer in range(DEPTH):
            g = norm_gains[layer]
            x = _half_ffn(x, g[0], g[1], ffn1_w_in[layer], ffn1_w_out[layer])
            xn = _rmsnorm(x, g[2])
            if layer < N_A_LAYERS:
                y, hr, hi = _s5_mixer(xn, h0_re[layer], h0_im[layer],
                                      ssm_lambda_re[layer], ssm_lambda_im[layer], ssm_log_step[layer],
                                      ssm_b_re[layer], ssm_b_im[layer], ssm_c_re[layer], ssm_c_im[layer],
                                      ssm_d[layer], ssm_w_glu[layer])
                ssm_re.append(hr)
                ssm_im.append(hi)
            else:
                b = layer - N_A_LAYERS
                if past_k is None:
                    y = _band_attention_prompt(xn, k, v, attn_w_q[b], attn_w_o[b], attn_rel_bias[b])
                else:
                    y = _band_attention_sample(xn, jnp.concatenate([past_k, k], axis=1),
                                               jnp.concatenate([past_v, v], axis=1),
                                               q_pos, k_pos, attn_w_q[b], attn_w_o[b], attn_rel_bias[b])
            x = x + _rmsnorm(y, g[3])
            x = _half_ffn(x, g[4], g[5], ffn2_w_in[layer], ffn2_w_out[layer])
            if layer == N_A_LAYERS - 1:
                k, v = jnp.split(_rmsnorm(x, kv_norm) @ w_kv, 2, axis=-1)
                k = k.reshape(n, l, N_HEADS, HEAD_DIM)
                v = v.reshape(n, l, N_HEADS, HEAD_DIM)
        return x, jnp.stack(ssm_re), jnp.stack(ssm_im), k, v

    bp, lp, _ = x_prompt.shape
    h0_zero = jnp.zeros((N_A_LAYERS, bp, N_GROUPS, SSM_STATE), state_ssm_re.dtype)
    y_prompt, ssm_re_p, ssm_im_p, k_p, v_p = trunk(x_prompt, h0_zero, h0_zero, None, None)
    keep = min(BAND_PAST, lp)
    k_prompt = k_p[:, lp - keep:]
    v_prompt = v_p[:, lp - keep:]

    y_sample, ssm_re_s, ssm_im_s, k_sample, v_sample = trunk(x_sample, state_ssm_re, state_ssm_im, cache_k, cache_v)

    return (y_prompt, y_sample, ssm_re_p, ssm_im_p, k_prompt, v_prompt, ssm_re_s, ssm_im_s, k_sample, v_sample)
```

```cpp
#include <hip/hip_runtime.h>
#include <hip/hip_cooperative_groups.h>
#include <cstdio>
namespace cg = cooperative_groups;

#ifndef MEGA
#define MEGA 1
#endif
#ifndef EXTRA_SYNCS
#define EXTRA_SYNCS 0
#endif
#ifndef ATTN_XCD_MAP
#define ATTN_XCD_MAP 0
#endif
#ifndef SMALL_ROWS
#define SMALL_ROWS 0
#endif
#ifndef EPI_TWICE
#define EPI_TWICE 0
#endif
#ifndef ATTN_Q64
#define ATTN_Q64 1
#endif
#ifndef REPEAT_MASK
#define REPEAT_MASK 0
#endif

#define LAS __attribute__((address_space(3)))
#define DI __device__ __forceinline__
typedef unsigned short bf16_t;
typedef short bf16x8 __attribute__((ext_vector_type(8)));
typedef float f32x4 __attribute__((ext_vector_type(4)));
typedef float f32x16 __attribute__((ext_vector_type(16)));
typedef float f32x2 __attribute__((ext_vector_type(2)));
typedef unsigned u32x4 __attribute__((ext_vector_type(4)));
typedef unsigned u32x2 __attribute__((ext_vector_type(2)));
typedef __bf16 bf16v2 __attribute__((ext_vector_type(2)));

constexpr int D = 1024, FF = 2816, NP = 16384, NS = 128, MALL = NP + NS, SEQ = 2048;
constexpr float EPS = 1e-6f;
constexpr float LOG2E = 1.4426950408889634f;

constexpr size_t SZ_WIN = 5632ull * 1024 * 2, SZ_WOUT = 1024ull * 2816 * 2, SZ_LAYER = 2 * (SZ_WIN + SZ_WOUT);
constexpr size_t OFF_WGLU = 4 * SZ_LAYER;
constexpr size_t OFF_WKV = OFF_WGLU + 2ull * 2048 * 1024 * 2;
constexpr size_t OFF_WQ = OFF_WKV + 2048ull * 1024 * 2;
constexpr size_t OFF_WO = OFF_WQ + 2ull * 1024 * 1024 * 2;
constexpr size_t OFF_XN = OFF_WO + 2ull * 1024 * 1024 * 2;
constexpr size_t OFF_ACT = OFF_XN + (size_t)MALL * D * 2;
constexpr size_t OFF_Y = OFF_ACT + (size_t)MALL * FF * 2;
constexpr size_t OFF_QB = OFF_Y + (size_t)MALL * D * 4;
constexpr size_t OFF_BAR = OFF_QB + (size_t)MALL * D * 2;
constexpr size_t WS_END = OFF_BAR + 16384;
constexpr size_t OFF_KB = 0;
constexpr size_t OFF_VT = SZ_LAYER;

constexpr size_t O_YS = 16777216, O_SRP = 16908288, O_SIP = 16973824, O_KP = 17039360, O_VP = 21233664,
                 O_SRS = 25427968, O_SIS = 25493504, O_KS = 25559040, O_VS = 25690112;

constexpr int LDS_BYTES = 131072 + 16;
constexpr int N_PHASES = 45;

struct Params {
    const float* in[25];
    float* out;
    unsigned char* ws;
    int ph_lo, ph_hi;
};

DI int otid() { int t = threadIdx.x; asm volatile("" : "+v"(t)); return t; }
DI int obid() { int b = blockIdx.x; asm volatile("" : "+s"(b)); return b; }
DI unsigned pk_bf16(float lo, float hi) { f32x2 v = {lo, hi}; bf16v2 b = __builtin_convertvector(v, bf16v2); return __builtin_bit_cast(unsigned, b); }
DI float bf_lo(unsigned u) { return __uint_as_float(u << 16); }
DI float bf_hi(unsigned u) { return __uint_as_float(u & 0xffff0000u); }
DI float fast_rcp(float x) { return __builtin_amdgcn_rcpf(x); }
DI float fast_exp2(float x) { return __builtin_amdgcn_exp2f(x); }
DI float sigmoidf_(float x) { return fast_rcp(1.0f + fast_exp2(-x * LOG2E)); }
DI float wave_sum(float v) {
#pragma unroll
    for (int o = 32; o > 0; o >>= 1) v += __shfl_xor(v, o);
    return v;
}
DI float wave_max(float v) {
#pragma unroll
    for (int o = 32; o > 0; o >>= 1) v = fmaxf(v, __shfl_xor(v, o));
    return v;
}

namespace pg8 {
constexpr int BM = 256, BK = 64, HALF = 128, HTB = HALF * BK * 2, NXCD = 8, WGM = 4;
DI int lds_byte(int r, int c) { const int st = (r >> 4) * 2 + (c >> 5), rr = r & 15, cc = c & 31, ob = rr * 64 + cc * 2; return st * 1024 + (ob ^ (((ob >> 9) & 1) << 5)); }
DI void stage_rc(int b, int& R, int& C) { const int st = b / 1024, sb = b % 1024, swz = sb ^ (((sb >> 9) & 1) << 5); R = (st >> 1) * 16 + swz / 64; C = (st & 1) * 32 + (swz % 64) / 2; }
struct Unit { int pm, pn; };
struct Gemm { const bf16_t* A; const bf16_t* Bt; int M, N, K; };
struct StaticOrder {
    int nM, nN, nwg, G, c;
    DI void init(int M, int N, int G_, int c_) { nM = M / BM; nN = N / BM; nwg = nM * nN; G = G_; c = c_; }
    DI bool next(int i, Unit& u) const {
        const long L = (long)i * G + c; if (L >= nwg) return false;
        int wgid = (int)L; { const int q = nwg / NXCD, r = nwg % NXCD, xcd = wgid % NXCD, off = wgid / NXCD; wgid = (xcd < r ? xcd * (q + 1) : r * (q + 1) + (xcd - r) * q) + off; }
        const int nig = WGM * nN, gid = wgid / nig, fm = gid * WGM, gsz = (nM - fm) < WGM ? (nM - fm) : WGM;
        u.pm = fm + ((wgid % nig) % gsz); u.pn = (wgid % nig) / gsz; return true;
    }
};

template <class Epi>
DI void epi_big(const Epi& E, const f32x4 (&acc)[2][2][4][2], const Unit& u, int wr, int wc, int fr, int fq) {
#pragma unroll
    for (int ai = 0; ai < 2; ++ai)
#pragma unroll
        for (int m = 0; m < 4; ++m) {
            const int row = u.pm * BM + ai * HALF + wr * 64 + m * 16 + fr;
            if constexpr (Epi::PAIR) E.apply2(row, u.pn, wc, fq, acc[ai][0][m][0], acc[ai][0][m][1], acc[ai][1][m][0], acc[ai][1][m][1]);
            else {
#pragma unroll
                for (int bj = 0; bj < 2; ++bj) E.apply(row, u.pn * BM + bj * HALF + wc * 32, fq, acc[ai][bj][m][0], acc[ai][bj][m][1]);
            }
        }
}

template <class Epi>
DI void gemm_phase(LAS unsigned char* lds, const Gemm g, const StaticOrder& S, const Epi& E) {
    const int tid = otid(), wid = __builtin_amdgcn_readfirstlane(tid >> 6), lane = tid & 63, wr = wid >> 2, wc = wid & 3, fr = lane & 15, fq = lane >> 4;
    const int K = g.K, nt = K / BK;
    unsigned voffA[2];
#pragma unroll
    for (int i = 0; i < 2; ++i) { int R, C; stage_rc(tid * 16 + i * 8192, R, C); voffA[i] = (unsigned)(R * K + C) * 2u; }
    const size_t kstep = (size_t)(BK * 2);
    const size_t hstep = (size_t)HALF * K * 2;
    const size_t tstep = 2 * hstep;
    const unsigned ldsw = (unsigned)wid * 1024u;
    const int aoff = lds_byte(wr * 64 + fr, fq * 8), boff = lds_byte(wc * 32 + fr, fq * 8);
#define PG8_SA(b, h) (((b) * 2 + (h)) * HTB)
#define PG8_SB(b, h) ((4 + (b) * 2 + (h)) * HTB)
#define PG8_STAGE(bufoff, gbase, voff) do { _Pragma("unroll") for (int _i = 0; _i < 2; ++_i) \
        __builtin_amdgcn_global_load_lds((const unsigned*)((const char*)(gbase) + (voff)[_i]), (LAS unsigned*)(lds + (bufoff) + ldsw + _i * 8192), 16, 0, 0); } while (0)
#define PG8_LDA(dst, b, h) do { _Pragma("unroll") for (int m = 0; m < 4; ++m) _Pragma("unroll") for (int k = 0; k < 2; ++k) dst[m][k] = *(const LAS bf16x8*)(lds + PG8_SA(b, h) + aoff + m * 2048 + k * 1024); } while (0)
#define PG8_LDB(dst, b, h) do { _Pragma("unroll") for (int n = 0; n < 2; ++n) _Pragma("unroll") for (int k = 0; k < 2; ++k) dst[n][k] = *(const LAS bf16x8*)(lds + PG8_SB(b, h) + boff + n * 2048 + k * 1024); } while (0)
#define PG8_MMA(ai, bj, At, Bt) do { __builtin_amdgcn_s_setprio(1); _Pragma("unroll") for (int m = 0; m < 4; ++m) _Pragma("unroll") for (int n = 0; n < 2; ++n) _Pragma("unroll") for (int k = 0; k < 2; ++k) \
        acc[ai][bj][m][n] = __builtin_amdgcn_mfma_f32_16x16x32_bf16(Bt[n][k], At[m][k], acc[ai][bj][m][n], 0, 0, 0); __builtin_amdgcn_s_setprio(0); } while (0)
#define PG8_WAIT_V(n) asm volatile("s_waitcnt vmcnt(" #n ")" ::: "memory")
#define PG8_WAIT_L(n) asm volatile("s_waitcnt lgkmcnt(" #n ")" ::: "memory")
#define PG8_BAR __builtin_amdgcn_s_barrier()
#define PG8_SCHED __builtin_amdgcn_sched_barrier(0)
    Unit cur, nxt; int ui = 0;
    if (!S.next(0, cur)) return;
    f32x4 acc[2][2][4][2];
#pragma unroll
    for (int a = 0; a < 2; ++a)
#pragma unroll
        for (int b = 0; b < 2; ++b)
#pragma unroll
            for (int m = 0; m < 4; ++m)
#pragma unroll
                for (int n = 0; n < 2; ++n) acc[a][b][m][n] = (f32x4){0.f, 0.f, 0.f, 0.f};
    bf16x8 At[4][2], B0[2][2], B1[2][2];
    const char* cA = (const char*)g.A + (size_t)cur.pm * tstep; const char* cB = (const char*)g.Bt + (size_t)cur.pn * tstep;
    PG8_STAGE(PG8_SB(0, 0), cB, voffA); PG8_STAGE(PG8_SB(0, 1), cB + hstep, voffA); PG8_STAGE(PG8_SA(0, 0), cA, voffA); PG8_STAGE(PG8_SA(0, 1), cA + hstep, voffA);
    if (wr == 1) PG8_BAR;
    PG8_WAIT_V(2); PG8_BAR;
    PG8_STAGE(PG8_SB(1, 0), cB + kstep, voffA); PG8_STAGE(PG8_SA(1, 0), cA + kstep, voffA); PG8_STAGE(PG8_SB(1, 1), cB + hstep + kstep, voffA);
    PG8_WAIT_V(6); PG8_BAR;
    for (;;) {
        const bool has_next = S.next(ui + 1, nxt);
        const char* nA = has_next ? (const char*)g.A + (size_t)nxt.pm * tstep : cA; const char* nB = has_next ? (const char*)g.Bt + (size_t)nxt.pn * tstep : cB;
        for (int t = 0; t < nt; t += 2) {
            const bool last = (t == nt - 2);
            const char* a1 = cA + (size_t)(t + 1) * kstep;
            const char* a2 = last ? nA : cA + (size_t)(t + 2) * kstep; const char* b2 = last ? nB : cB + (size_t)(t + 2) * kstep;
            const char* a3 = a2 + kstep; const char* b3 = b2 + kstep;
            PG8_LDB(B0, 0, 0); PG8_LDB(B1, 0, 1); PG8_SCHED; PG8_LDA(At, 0, 0); PG8_STAGE(PG8_SA(1, 1), a1 + hstep, voffA);
            PG8_WAIT_V(8); PG8_WAIT_L(0); PG8_BAR; PG8_MMA(0, 0, At, B0); PG8_MMA(0, 1, At, B1); PG8_BAR; PG8_SCHED;
            PG8_LDA(At, 0, 1); PG8_STAGE(PG8_SB(0, 0), b2, voffA); PG8_STAGE(PG8_SB(0, 1), b2 + hstep, voffA); PG8_STAGE(PG8_SA(0, 0), a2, voffA);
            PG8_WAIT_V(8); PG8_WAIT_L(0); PG8_BAR; PG8_MMA(1, 0, At, B0); PG8_MMA(1, 1, At, B1); PG8_BAR; PG8_SCHED;
            PG8_LDB(B0, 1, 0); PG8_LDB(B1, 1, 1); PG8_SCHED; PG8_LDA(At, 1, 0); PG8_STAGE(PG8_SA(0, 1), a2 + hstep, voffA);
            PG8_WAIT_V(8); PG8_WAIT_L(0); PG8_BAR; PG8_MMA(0, 0, At, B0); PG8_MMA(0, 1, At, B1); PG8_BAR; PG8_SCHED;
            PG8_LDA(At, 1, 1); PG8_STAGE(PG8_SB(1, 0), b3, voffA); PG8_STAGE(PG8_SB(1, 1), b3 + hstep, voffA); PG8_STAGE(PG8_SA(1, 0), a3, voffA);
            PG8_WAIT_V(8); PG8_WAIT_L(0); PG8_BAR; PG8_MMA(1, 0, At, B0); PG8_MMA(1, 1, At, B1); PG8_BAR; PG8_SCHED;
        }
        if (wr == 0) PG8_BAR;
        epi_big(E, acc, cur, wr, wc, fr, fq);
        if (EPI_TWICE) { asm volatile("" ::: "memory"); epi_big(E, acc, cur, wr, wc, fr, fq); }
        if (!has_next) break;
#pragma unroll
        for (int a = 0; a < 2; ++a)
#pragma unroll
            for (int b = 0; b < 2; ++b)
#pragma unroll
                for (int m = 0; m < 4; ++m)
#pragma unroll
                    for (int n = 0; n < 2; ++n) acc[a][b][m][n] = (f32x4){0.f, 0.f, 0.f, 0.f};
        cur = nxt; cA = nA; cB = nB; ++ui;
        if (wr == 1) PG8_BAR;
    }
    PG8_WAIT_V(0);
    PG8_BAR;
#undef PG8_SA
#undef PG8_SB
#undef PG8_STAGE
#undef PG8_LDA
#undef PG8_LDB
#undef PG8_MMA
#undef PG8_WAIT_V
#undef PG8_WAIT_L
#undef PG8_BAR
#undef PG8_SCHED
}
}

template <class Epi>
DI void small_gemm(unsigned char* lds, const bf16_t* A  , const bf16_t* Bt, int N, int K, const Epi& E) {
    const int tid = otid(), wid = tid >> 6, lane = tid & 63, fr = lane & 15, fq = lane >> 4;
    const int G = gridDim.x, nun = (N / 32) * 8, kw = K / 8, nks = kw / 32;
    f32x4* red = (f32x4*)lds;
    for (int u = (G - 1 - obid()); u < nun; u += G) {
        const int q = u >> 3, rb = u & 7;
        const bf16_t* ap = A + (size_t)(rb * 16 + fr) * K + wid * kw + fq * 8;
        const bf16_t* b0 = Bt + (size_t)(q * 32 + fr) * K + wid * kw + fq * 8;
        const bf16_t* b1 = b0 + (size_t)16 * K;
        f32x4 c0 = {0.f, 0.f, 0.f, 0.f}, c1 = {0.f, 0.f, 0.f, 0.f};
        if (nks == 11) {
            bf16x8 af[11], w0[11], w1[11];
#pragma unroll
            for (int j = 0; j < 11; ++j) { af[j] = *(const bf16x8*)(ap + j * 32); w0[j] = *(const bf16x8*)(b0 + j * 32); w1[j] = *(const bf16x8*)(b1 + j * 32); }
            __builtin_amdgcn_sched_barrier(0);
#pragma unroll
            for (int j = 0; j < 11; ++j) {
                c0 = __builtin_amdgcn_mfma_f32_16x16x32_bf16(w0[j], af[j], c0, 0, 0, 0);
                c1 = __builtin_amdgcn_mfma_f32_16x16x32_bf16(w1[j], af[j], c1, 0, 0, 0);
            }
            __builtin_amdgcn_sched_barrier(0);
        } else if (nks == 4) {
            bf16x8 af[4], w0[4], w1[4];
#pragma unroll
            for (int j = 0; j < 4; ++j) { af[j] = *(const bf16x8*)(ap + j * 32); w0[j] = *(const bf16x8*)(b0 + j * 32); w1[j] = *(const bf16x8*)(b1 + j * 32); }
            __builtin_amdgcn_sched_barrier(0);
#pragma unroll
            for (int j = 0; j < 4; ++j) {
                c0 = __builtin_amdgcn_mfma_f32_16x16x32_bf16(w0[j], af[j], c0, 0, 0, 0);
                c1 = __builtin_amdgcn_mfma_f32_16x16x32_bf16(w1[j], af[j], c1, 0, 0, 0);
            }
            __builtin_amdgcn_sched_barrier(0);
        } else {
            for (int ks = 0; ks < nks; ++ks) {
                const bf16x8 af = *(const bf16x8*)(ap + ks * 32), w0 = *(const bf16x8*)(b0 + ks * 32), w1 = *(const bf16x8*)(b1 + ks * 32);
                c0 = __builtin_amdgcn_mfma_f32_16x16x32_bf16(w0, af, c0, 0, 0, 0);
                c1 = __builtin_amdgcn_mfma_f32_16x16x32_bf16(w1, af, c1, 0, 0, 0);
            }
        }
        red[(wid * 2 + 0) * 64 + lane] = c0; red[(wid * 2 + 1) * 64 + lane] = c1;
        __syncthreads();
        if (wid == 0) {
            f32x4 s0 = red[lane], s1 = red[64 + lane];
#pragma unroll
            for (int w = 1; w < 8; ++w) { s0 += red[(w * 2) * 64 + lane]; s1 += red[(w * 2 + 1) * 64 + lane]; }
            E.apply(NP + rb * 16 + fr, q * 32, fq, s0, s1);
        }
        __syncthreads();
    }
}

template <class Epi>
DI void small_gemm3(unsigned char* lds, const bf16_t* A, const bf16_t* Bt, int N, const Epi& E) {
    constexpr int K = 1024, kw = 128;
    const int tid = otid(), wid = tid >> 6, lane = tid & 63, fr = lane & 15, fq = lane >> 4;
    const int G = gridDim.x, nun = (N / 32) * 8;
    f32x4* red = (f32x4*)lds;
    for (int u0 = (G - 1 - obid()); u0 < nun; u0 += 3 * G) {
        bf16x8 af[3][4], w0[3][4], w1[3][4];
#pragma unroll
        for (int t = 0; t < 3; ++t) {
            const int u = u0 + t * G, uu = u < nun ? u : u0;
            const int q = uu >> 3, rb = uu & 7;
            const bf16_t* ap = A + (size_t)(rb * 16 + fr) * K + wid * kw + fq * 8;
            const bf16_t* b0 = Bt + (size_t)(q * 32 + fr) * K + wid * kw + fq * 8;
            const bf16_t* b1 = b0 + (size_t)16 * K;
#pragma unroll
            for (int j = 0; j < 4; ++j) { af[t][j] = *(const bf16x8*)(ap + j * 32); w0[t][j] = *(const bf16x8*)(b0 + j * 32); w1[t][j] = *(const bf16x8*)(b1 + j * 32); }
        }
        __builtin_amdgcn_sched_barrier(0);
#pragma unroll
        for (int t = 0; t < 3; ++t) {
            f32x4 c0 = {0.f, 0.f, 0.f, 0.f}, c1 = {0.f, 0.f, 0.f, 0.f};
#pragma unroll
            for (int j = 0; j < 4; ++j) {
                c0 = __builtin_amdgcn_mfma_f32_16x16x32_bf16(w0[t][j], af[t][j], c0, 0, 0, 0);
                c1 = __builtin_amdgcn_mfma_f32_16x16x32_bf16(w1[t][j], af[t][j], c1, 0, 0, 0);
            }
            red[((t * 8 + wid) * 2 + 0) * 64 + lane] = c0; red[((t * 8 + wid) * 2 + 1) * 64 + lane] = c1;
        }
        __syncthreads();
        if (wid < 3) {
            const int u = u0 + wid * G;
            if (u < nun) {
                f32x4 s0 = red[((wid * 8) * 2) * 64 + lane], s1 = red[((wid * 8) * 2 + 1) * 64 + lane];
#pragma unroll
                for (int w = 1; w < 8; ++w) { s0 += red[((wid * 8 + w) * 2) * 64 + lane]; s1 += red[((wid * 8 + w) * 2 + 1) * 64 + lane]; }
                E.apply(NP + (u & 7) * 16 + fr, (u >> 3) * 32, fq, s0, s1);
            }
        }
        __syncthreads();
    }
}

template <class Epi>
DI void small_gemm_rows(const bf16_t* A, const bf16_t* Bt, int N, int K, const Epi& E, int first_wg) {
    const int tid = otid(), wid = tid >> 6, lane = tid & 63, fr = lane & 15, fq = lane >> 4;
    const int G = gridDim.x, bid = obid(), nun = N / 32, nks = K / 32;
    if (bid < first_wg) return;
    const int stride = G - first_wg;
    const bf16_t* ap = A + (size_t)(wid * 16 + fr) * K + fq * 8;
    for (int u = G - 1 - bid; u < nun; u += stride) {
        const bf16_t* b0 = Bt + (size_t)(u * 32 + fr) * K + fq * 8;
        const bf16_t* b1 = b0 + (size_t)16 * K;
        f32x4 c0 = {0.f, 0.f, 0.f, 0.f}, c1 = {0.f, 0.f, 0.f, 0.f};
        for (int ks0 = 0; ks0 < nks; ks0 += 8) {
            bf16x8 af[8], w0[8], w1[8];
#pragma unroll
            for (int j = 0; j < 8; ++j) { af[j] = *(const bf16x8*)(ap + (ks0 + j) * 32); w0[j] = *(const bf16x8*)(b0 + (ks0 + j) * 32); w1[j] = *(const bf16x8*)(b1 + (ks0 + j) * 32); }
            __builtin_amdgcn_sched_barrier(0);
#pragma unroll
            for (int j = 0; j < 8; ++j) {
                c0 = __builtin_amdgcn_mfma_f32_16x16x32_bf16(w0[j], af[j], c0, 0, 0, 0);
                c1 = __builtin_amdgcn_mfma_f32_16x16x32_bf16(w1[j], af[j], c1, 0, 0, 0);
            }
            __builtin_amdgcn_sched_barrier(0);
        }
        E.apply(NP + wid * 16 + fr, u * 32, fq, c0, c1);
    }
}

struct EpiSwiglu {
    static constexpr bool PAIR = true;
    bf16_t* act;
    DI void apply(int row, int c32, int fq, f32x4 g, f32x4 u) const {
        float r[4];
#pragma unroll
        for (int j = 0; j < 4; ++j) r[j] = g[j] * sigmoidf_(g[j]) * u[j];
        u32x2 w; w.x = pk_bf16(r[0], r[1]); w.y = pk_bf16(r[2], r[3]);
        const int col = (c32 >> 8) * 128 + ((c32 >> 5) & 3) * 32 + 8 * fq + ((c32 >> 7) & 1) * 4;
        *(u32x2*)(act + (size_t)row * FF + col) = w;
    }
    DI void apply2(int row, int pn, int wc, int fq, f32x4 g0, f32x4 u0, f32x4 g1, f32x4 u1) const {
        float r[8];
#pragma unroll
        for (int j = 0; j < 4; ++j) { r[j] = g0[j] * sigmoidf_(g0[j]) * u0[j]; r[4 + j] = g1[j] * sigmoidf_(g1[j]) * u1[j]; }
        u32x4 w; w.x = pk_bf16(r[0], r[1]); w.y = pk_bf16(r[2], r[3]); w.z = pk_bf16(r[4], r[5]); w.w = pk_bf16(r[6], r[7]);
        *(u32x4*)(act + (size_t)row * FF + pn * 128 + wc * 32 + 8 * fq) = w;
    }
};
struct EpiGlu {
    static constexpr bool PAIR = true;
    bf16_t* y;
    DI void apply(int row, int c32, int fq, f32x4 v, f32x4 g) const {
        float r[4];
#pragma unroll
        for (int j = 0; j < 4; ++j) r[j] = v[j] * sigmoidf_(g[j]);
        u32x2 w; w.x = pk_bf16(r[0], r[1]); w.y = pk_bf16(r[2], r[3]);
        const int col = (c32 >> 8) * 128 + ((c32 >> 5) & 3) * 32 + 8 * fq + ((c32 >> 7) & 1) * 4;
        *(u32x2*)(y + (size_t)row * D + col) = w;
    }
    DI void apply2(int row, int pn, int wc, int fq, f32x4 v0, f32x4 g0, f32x4 v1, f32x4 g1) const {
        float r[8];
#pragma unroll
        for (int j = 0; j < 4; ++j) { r[j] = v0[j] * sigmoidf_(g0[j]); r[4 + j] = v1[j] * sigmoidf_(g1[j]); }
        u32x4 w; w.x = pk_bf16(r[0], r[1]); w.y = pk_bf16(r[2], r[3]); w.z = pk_bf16(r[4], r[5]); w.w = pk_bf16(r[6], r[7]);
        *(u32x4*)(y + (size_t)row * D + pn * 128 + wc * 32 + 8 * fq) = w;
    }
};
struct EpiF32 {
    static constexpr bool PAIR = false;
    float* y;
    DI void apply(int row, int c32, int fq, f32x4 v0, f32x4 v1) const {
        float* p = y + (size_t)row * D + c32 + 4 * fq;
        *(f32x4*)p = v0; *(f32x4*)(p + 16) = v1;
    }
};
struct EpiBf16 {
    static constexpr bool PAIR = false;
    bf16_t* o;
    DI void apply(int row, int c32, int fq, f32x4 v0, f32x4 v1) const {
        u32x4 w; w.x = pk_bf16(v0[0], v0[1]); w.y = pk_bf16(v0[2], v0[3]); w.z = pk_bf16(v1[0], v1[1]); w.w = pk_bf16(v1[2], v1[3]);
        *(u32x4*)(o + (size_t)row * D + c32 + 8 * fq) = w;
    }
};
struct EpiKV {
    static constexpr bool PAIR = false;
    bf16_t* kb; bf16_t* vt; float* out;
    DI void one(int row, int c, f32x4 v) const {
        if (row >= NP) {
            const int r = row - NP;
            if (c < D) *(f32x4*)(out + O_KS + (size_t)r * D + c) = v;
            else *(f32x4*)(out + O_VS + (size_t)r * D + (c - D)) = v;
            return;
        }
        const int n = row >> 11, pos = row & 2047;
        if (c < D) {
            u32x2 a; a.x = pk_bf16(v[0], v[1]); a.y = pk_bf16(v[2], v[3]);
            *(u32x2*)(kb + (size_t)row * D + c) = a;
            if (pos >= 1536) *(f32x4*)(out + O_KP + ((size_t)n * 512 + (pos - 1536)) * D + c) = v;
        } else {
            const int cv = c - D;
            const unsigned p01 = pk_bf16(v[0], v[1]), p23 = pk_bf16(v[2], v[3]);
            const int pp = (pos & ~15) | (((pos >> 2) & 1) << 3) | (((pos >> 3) & 1) << 2) | (pos & 3);
            bf16_t* vp = vt + ((size_t)n * D + cv) * SEQ + pp;
            vp[0] = (bf16_t)(p01 & 0xffffu); vp[SEQ] = (bf16_t)(p01 >> 16); vp[2 * SEQ] = (bf16_t)(p23 & 0xffffu); vp[3 * SEQ] = (bf16_t)(p23 >> 16);
            if (pos >= 1536) *(f32x4*)(out + O_VP + ((size_t)n * 512 + (pos - 1536)) * D + cv) = v;
        }
    }
    DI void apply(int row, int c32, int fq, f32x4 v0, f32x4 v1) const { one(row, c32 + 4 * fq, v0); one(row, c32 + 16 + 4 * fq, v1); }
};

DI void convert_tile(unsigned char* lds, const float* src, bf16_t* dst, int K, int N, int halfN, int tile) {
    float* T = (float*)lds;
    const int tid = otid();
    const int ntk = K / 64, tn = tile / ntk, tk = tile % ntk, n0 = tn * 256, k0 = tk * 64;
    {
        const int n4 = (tid & 63) * 4, kk = tid >> 6;
        const int np = n0 + n4;
        const int col = halfN == -1 ? ((np & ~31) + 8 * ((np >> 2) & 3) + 4 * ((np >> 4) & 1) + (np & 3)) : (halfN == 2816 || halfN == 1024) ? (((np >> 4) & 1) * halfN + (np >> 8) * 128 + ((np >> 5) & 3) * 32 + ((np >> 2) & 3) * 8 + ((np >> 7) & 1) * 4 + (np & 3))
                      : halfN ? (((np >> 4) & 1) * halfN + (np >> 5) * 16 + (np & 15)) : np;
        f32x4 v[8];
#pragma unroll
        for (int h = 0; h < 8; ++h) v[h] = __builtin_nontemporal_load((const f32x4*)(src + (size_t)(k0 + kk + 8 * h) * N + col));
        __builtin_amdgcn_sched_barrier(0);
#pragma unroll
        for (int h = 0; h < 8; ++h) { float* t = T + (kk + 8 * h) * 257 + n4; t[0] = v[h][0]; t[1] = v[h][1]; t[2] = v[h][2]; t[3] = v[h][3]; }
    }
    __syncthreads();
    {
        const int k8 = (tid & 7) * 8, nr = tid >> 3;
#pragma unroll
        for (int q = 0; q < 4; ++q) {
            const int n = nr + 64 * q;
            float f[8];
#pragma unroll
            for (int j = 0; j < 8; ++j) f[j] = T[(k8 + j) * 257 + n];
            u32x4 w; w.x = pk_bf16(f[0], f[1]); w.y = pk_bf16(f[2], f[3]); w.z = pk_bf16(f[4], f[5]); w.w = pk_bf16(f[6], f[7]);
            *(u32x4*)(dst + (size_t)(n0 + n) * K + k0 + k8) = w;
        }
    }
    __syncthreads();
}

struct ConvJob { const float* src; bf16_t* dst; int K, N, halfN; };
DI ConvJob conv_job(const Params& P, int j) {
    ConvJob c;
    if (j < 16) {
        const int L = j >> 2, kind = j & 3;
        if ((kind & 1) == 0) { c.src = P.in[kind == 0 ? 7 : 9] + (size_t)L * 1024 * 5632; c.dst = (bf16_t*)(P.ws + L * SZ_LAYER + (kind == 0 ? 0 : SZ_WIN + SZ_WOUT)); c.K = 1024; c.N = 5632; c.halfN = 2816; }
        else { c.src = P.in[kind == 1 ? 8 : 10] + (size_t)L * 2816 * 1024; c.dst = (bf16_t*)(P.ws + L * SZ_LAYER + (kind == 1 ? SZ_WIN : 2 * SZ_WIN + SZ_WOUT)); c.K = 2816; c.N = 1024; c.halfN = -1; }
    } else if (j < 18) { const int l = j - 16; c.src = P.in[19] + (size_t)l * 1024 * 2048; c.dst = (bf16_t*)(P.ws + OFF_WGLU) + (size_t)l * 2048 * 1024; c.K = 1024; c.N = 2048; c.halfN = 1024; }
    else if (j == 18) { c.src = P.in[21]; c.dst = (bf16_t*)(P.ws + OFF_WKV); c.K = 1024; c.N = 2048; c.halfN = 0; }
    else if (j < 21) { const int b = j - 19; c.src = P.in[22] + (size_t)b * 1024 * 1024; c.dst = (bf16_t*)(P.ws + OFF_WQ) + (size_t)b * 1024 * 1024; c.K = 1024; c.N = 1024; c.halfN = -1; }
    else { const int b = j - 21; c.src = P.in[23] + (size_t)b * 1024 * 1024; c.dst = (bf16_t*)(P.ws + OFF_WO) + (size_t)b * 1024 * 1024; c.K = 1024; c.N = 1024; c.halfN = -1; }
    return c;
}
DI int conv_group(int j) { return (j >= 8 && j <= 15) ? 1 : 0; }
DI void convert_deferred(const Params& P, unsigned char* lds, int slot, int first_wg) {
    const int bid = obid(), G = gridDim.x;
    if (bid < first_wg) return;
    const int lo = slot < 4 ? slot * 264 : 1056 + (slot - 4) * 528, hi = slot < 4 ? lo + 264 : lo + 528, stride = G - first_wg;
    int base = 0;
    for (int j = 8; j < 16; ++j) {
        const ConvJob c = conv_job(P, j);
        const int nt = (c.N / 256) * (c.K / 64);
        const int a = base > lo ? base : lo, b = (base + nt) < hi ? (base + nt) : hi;
        if (a < b) {
            int g = a + ((bid - first_wg) - (a - lo) % stride + stride) % stride;
            for (; g < b; g += stride) convert_tile(lds, c.src, c.dst, c.K, c.N, c.halfN, g - base);
        }
        base += nt;
    }
}
DI void convert_phase(const Params& P, unsigned char* lds) {
    const int G = gridDim.x;
    int base = 0;
    for (int j = 0; j < 23; ++j) {
        if (conv_group(j) != 0) continue;
        const ConvJob c = conv_job(P, j);
        const int nt = (c.N / 256) * (c.K / 64);
        int first = (obid() - base % G + G) % G;
        for (int t = first; t < nt; t += G) convert_tile(lds, c.src, c.dst, c.K, c.N, c.halfN, t);
        base += nt;
    }
}
DI void convert_tile64(unsigned char* wl  , const ConvJob& c, int tile) {
    float* T = (float*)wl;
    const int lane = otid() & 63;
    const int ntk = c.K / 64, tn = tile / ntk, tk = tile % ntk, n0 = tn * 64, k0 = tk * 64;
    {
        const int n4 = (lane & 15) * 4, kq = lane >> 4;
        const int np = n0 + n4;
        const int col = c.halfN == -1 ? ((np & ~31) + 8 * ((np >> 2) & 3) + 4 * ((np >> 4) & 1) + (np & 3)) : (c.halfN == 2816 || c.halfN == 1024) ? (((np >> 4) & 1) * c.halfN + (np >> 8) * 128 + ((np >> 5) & 3) * 32 + ((np >> 2) & 3) * 8 + ((np >> 7) & 1) * 4 + (np & 3))
                      : c.halfN ? (((np >> 4) & 1) * c.halfN + (np >> 5) * 16 + (np & 15)) : np;
        f32x4 v[16];
#pragma unroll
        for (int h = 0; h < 16; ++h) v[h] = *(const f32x4*)(c.src + (size_t)(k0 + 4 * h + kq) * c.N + col);
        __builtin_amdgcn_sched_barrier(0);
#pragma unroll
        for (int h = 0; h < 16; ++h) { float* t = T + (4 * h + kq) * 65 + n4; t[0] = v[h][0]; t[1] = v[h][1]; t[2] = v[h][2]; t[3] = v[h][3]; }
    }
    {
        const int k8 = (lane & 7) * 8, nr = lane >> 3;
#pragma unroll
        for (int q = 0; q < 8; ++q) {
            const int n = nr + 8 * q;
            float f[8];
#pragma unroll
            for (int j = 0; j < 8; ++j) f[j] = T[(k8 + j) * 65 + n];
            u32x4 w; w.x = pk_bf16(f[0], f[1]); w.y = pk_bf16(f[2], f[3]); w.z = pk_bf16(f[4], f[5]); w.w = pk_bf16(f[6], f[7]);
            *(u32x4*)(c.dst + (size_t)(n0 + n) * c.K + k0 + k8) = w;
        }
    }
}
DI void convert_waves(const Params& P, unsigned char* wl, int group, int slot, int nslots) {
    int base = 0;
    for (int j = 0; j < 23; ++j) {
        if (conv_group(j) != group) continue;
        const ConvJob c = conv_job(P, j);
        const int nt = (c.N / 64) * (c.K / 64);
        int first = (slot - base % nslots + nslots) % nslots;
        for (int t = first; t < nt; t += nslots) convert_tile64(wl, c, t);
        base += nt;
    }
}

DI void rowpass(const Params& P, const bf16_t* Y, const float* gpost, float coef, const float* gnext, const float* gkv, bool first) {
    const int tid = otid(), wid = tid >> 6, lane = tid & 63;
    bf16_t* XB = (bf16_t*)(P.ws + OFF_Y) + (size_t)MALL * D;
    bf16_t* XN = (bf16_t*)(P.ws + OFF_XN);
    bf16_t* XKV = (bf16_t*)(P.ws + OFF_QB);
    const bool last = !first && gnext == nullptr;
    f32x4 gp[4], gn[4], gk[4];
#pragma unroll
    for (int i = 0; i < 4; ++i) {
        gp[i] = Y ? *(const f32x4*)(gpost + lane * 4 + 256 * i) : (f32x4){0.f, 0.f, 0.f, 0.f};
        gn[i] = gnext ? *(const f32x4*)(gnext + lane * 4 + 256 * i) : (f32x4){0.f, 0.f, 0.f, 0.f};
        gk[i] = gkv ? *(const f32x4*)(gkv + lane * 4 + 256 * i) : (f32x4){0.f, 0.f, 0.f, 0.f};
    }
    const int half = MALL / 2;
    for (int r0 = obid() * 8 + wid; r0 < half; r0 += gridDim.x * 8) {
        f32x4 x[2][4]; u32x2 y[2][4];
#pragma unroll
        for (int q = 0; q < 2; ++q) {
            const int row = r0 + q * half;
            if (first) {
                const float* src = row < NP ? P.in[0] + (size_t)row * D : P.in[1] + (size_t)(row - NP) * D;
#pragma unroll
                for (int i = 0; i < 4; ++i) x[q][i] = __builtin_nontemporal_load((const f32x4*)(src + lane * 4 + 256 * i));
            } else {
#pragma unroll
                for (int i = 0; i < 4; ++i) { const u32x2 w = __builtin_nontemporal_load((const u32x2*)(XB + (size_t)row * D + lane * 4 + 256 * i)); x[q][i] = (f32x4){bf_lo(w.x), bf_hi(w.x), bf_lo(w.y), bf_hi(w.y)}; }
            }
            if (Y) {
#pragma unroll
                for (int i = 0; i < 4; ++i) y[q][i] = __builtin_nontemporal_load((const u32x2*)(Y + (size_t)row * D + lane * 4 + 256 * i));
            }
        }
#pragma unroll
        for (int q = 0; q < 2; ++q) {
            const int row = r0 + q * half;
            if (Y) {
                f32x4 yf[4]; float ss = 0.f;
#pragma unroll
                for (int i = 0; i < 4; ++i) { yf[i] = (f32x4){bf_lo(y[q][i].x), bf_hi(y[q][i].x), bf_lo(y[q][i].y), bf_hi(y[q][i].y)}; ss += yf[i][0] * yf[i][0] + yf[i][1] * yf[i][1] + yf[i][2] * yf[i][2] + yf[i][3] * yf[i][3]; }
                ss = wave_sum(ss);
                const float r = coef * __builtin_amdgcn_rsqf(ss * (1.0f / D) + EPS);
#pragma unroll
                for (int i = 0; i < 4; ++i) x[q][i] += yf[i] * gp[i] * r;
            }
            if (last) {
#pragma unroll
                for (int i = 0; i < 4; ++i) *(f32x4*)(P.out + (size_t)row * D + lane * 4 + 256 * i) = x[q][i];
            } else {
#pragma unroll
                for (int i = 0; i < 4; ++i) { u32x2 w; w.x = pk_bf16(x[q][i][0], x[q][i][1]); w.y = pk_bf16(x[q][i][2], x[q][i][3]); *(u32x2*)(XB + (size_t)row * D + lane * 4 + 256 * i) = w; }
            }
            if (gnext) {
                float ss = 0.f;
#pragma unroll
                for (int i = 0; i < 4; ++i) ss += x[q][i][0] * x[q][i][0] + x[q][i][1] * x[q][i][1] + x[q][i][2] * x[q][i][2] + x[q][i][3] * x[q][i][3];
                ss = wave_sum(ss);
                const float r = __builtin_amdgcn_rsqf(ss * (1.0f / D) + EPS);
#pragma unroll
                for (int i = 0; i < 4; ++i) {
                    const f32x4 v = x[q][i] * gn[i] * r;
                    u32x2 w; w.x = pk_bf16(v[0], v[1]); w.y = pk_bf16(v[2], v[3]);
                    *(u32x2*)(XN + (size_t)row * D + lane * 4 + 256 * i) = w;
                }
                if (gkv) {
#pragma unroll
                    for (int i = 0; i < 4; ++i) {
                        const f32x4 v = x[q][i] * gk[i] * r;
                        u32x2 w; w.x = pk_bf16(v[0], v[1]); w.y = pk_bf16(v[2], v[3]);
                        *(u32x2*)(XKV + (size_t)row * D + lane * 4 + 256 * i) = w;
                    }
                }
            }
        }
    }
}

DI double d_exp_small(double x) {
    const double y = x * 0.0625; double s = 1.0;
#pragma unroll
    for (int k = 14; k >= 1; --k) s = 1.0 + s * y * (1.0 / (double)k);
    s *= s; s *= s; s *= s; s *= s; return s;
}
DI void d_sincos(double a, double& sn, double& cs) {
    const double TWO_PI = 6.283185307179586476925286766559, INV_TWO_PI = 0.15915494309189533576888376337251;
    const double k = __builtin_rint(a * INV_TWO_PI); const double r = a - k * TWO_PI;
    const double r2 = r * r; double s = 1.0, c = 1.0;
#pragma unroll
    for (int i = 14; i >= 1; --i) { s = 1.0 - s * r2 * (1.0 / (double)((2 * i) * (2 * i + 1))); c = 1.0 - c * r2 * (1.0 / (double)((2 * i - 1) * (2 * i))); }
    sn = s * r; cs = c;
}
DI float gelu_tanh(float x) {
    const float z = 0.7978845608028654f * (x + 0.044715f * x * x * x);
    return x * fast_rcp(1.0f + fast_exp2(-2.0f * LOG2E * z));
}
DI void s5_consts(const Params& P, int l, int g, int p, float& ar, float& ai, float& cr, float& ci) {
    const int gp = (l * 64 + g) * 64 + p;
    const double lr = (double)P.in[11][gp], li = (double)P.in[12][gp];
    const double st = d_exp_small((double)P.in[13][l * 64 + g]);
    const double er = d_exp_small(lr * st); double sn, cs; d_sincos(li * st, sn, cs);
    const double dar = er * cs, dai = er * sn;
    const double den = 1.0 / (lr * lr + li * li);
    ar = (float)dar; ai = (float)dai;
    cr = (float)(((dar - 1.0) * lr + dai * li) * den); ci = (float)((dai * lr - (dar - 1.0) * li) * den);
}

DI void s5_item2(const Params& P, unsigned char* wl  , int l, int pair, bool prompt, int g) {
    const int lane = otid() & 63, n = lane & 31, hh = lane >> 5, fr = lane & 15, fq = lane >> 4;
    const int L = prompt ? SEQ : 16;
    const bf16_t* XN = (const bf16_t*)(P.ws + OFF_XN);
    bf16_t* YO = (bf16_t*)(P.ws + OFF_QB);
    float ar0, ai0, ar1, ai1;
    bf16x8 bfr[4];
    {
        float cr0, ci0, cr1, ci1;
        s5_consts(P, l, g, n, ar0, ai0, cr0, ci0);
        s5_consts(P, l, g, 32 + n, ar1, ai1, cr1, ci1);
#pragma unroll
        for (int pb = 0; pb < 2; ++pb) {
            const int gp = (l * 64 + g) * 64 + pb * 32 + n;
            const float crf = pb ? cr1 : cr0, cif = pb ? ci1 : ci0;
            const float* br = P.in[14] + (size_t)gp * 16 + 8 * hh; const float* bi = P.in[15] + (size_t)gp * 16 + 8 * hh;
            const f32x4 r0 = *(const f32x4*)br, r1 = *(const f32x4*)(br + 4), i0 = *(const f32x4*)bi, i1 = *(const f32x4*)(bi + 4);
            u32x4 wr, wi;
            wr.x = pk_bf16(crf * r0[0] - cif * i0[0], crf * r0[1] - cif * i0[1]); wr.y = pk_bf16(crf * r0[2] - cif * i0[2], crf * r0[3] - cif * i0[3]);
            wr.z = pk_bf16(crf * r1[0] - cif * i1[0], crf * r1[1] - cif * i1[1]); wr.w = pk_bf16(crf * r1[2] - cif * i1[2], crf * r1[3] - cif * i1[3]);
            wi.x = pk_bf16(crf * i0[0] + cif * r0[0], crf * i0[1] + cif * r0[1]); wi.y = pk_bf16(crf * i0[2] + cif * r0[2], crf * i0[3] + cif * r0[3]);
            wi.z = pk_bf16(crf * i1[0] + cif * r1[0], crf * i1[1] + cif * r1[1]); wi.w = pk_bf16(crf * i1[2] + cif * r1[2], crf * i1[3] + cif * r1[3]);
            bfr[pb] = __builtin_bit_cast(bf16x8, wr); bfr[2 + pb] = __builtin_bit_cast(bf16x8, wi);
        }
    }
    bf16x8 cf[4];
    {
        const float* cr = P.in[16] + ((size_t)(l * 64 + g) * 16 + fr) * 64; const float* ci = P.in[17] + ((size_t)(l * 64 + g) * 16 + fr) * 64;
#pragma unroll
        for (int ks = 0; ks < 4; ++ks) {
            const int n0 = 8 * ks + 2 * fq;
            const f32x2 ra = *(const f32x2*)(cr + n0), rb = *(const f32x2*)(cr + 32 + n0), ia = *(const f32x2*)(ci + n0), ib = *(const f32x2*)(ci + 32 + n0);
            u32x4 w; w.x = pk_bf16(ra.x, -ia.x); w.y = pk_bf16(rb.x, -ib.x); w.z = pk_bf16(ra.y, -ia.y); w.w = pk_bf16(rb.y, -ib.y);
            cf[ks] = __builtin_bit_cast(bf16x8, w);
        }
    }
    const f32x4 d4 = *(const f32x4*)(P.in[18] + (size_t)l * D + g * 16 + 4 * fq);
    float hr0 = 0.f, hi0 = 0.f, hr1 = 0.f, hi1 = 0.f;
    const int seqh = pair * 2 + hh;
    if (!prompt) { const size_t si = ((size_t)(l * 8 + seqh) * 64 + g) * 64 + n; hr0 = P.in[2][si]; hi0 = P.in[3][si]; hr1 = P.in[2][si + 32]; hi1 = P.in[3][si + 32]; }
    const int sm = (n >> 2) & 1, im = (n & 3) + 4 * (n >> 3);
    const size_t rbA = prompt ? (size_t)(pair * 2 + sm) * SEQ : (size_t)NP + (size_t)(pair * 2 + sm) * 16;
    const bf16_t* ua = XN + (rbA + im) * D + g * 16 + 8 * hh;
    const size_t rb0 = prompt ? (size_t)(pair * 2) * SEQ : (size_t)NP + (size_t)(pair * 2) * 16;
    const size_t rb1 = prompt ? rb0 + SEQ : rb0 + 16;
    const bf16_t* ue0 = XN + (rb0 + fr) * D + g * 16 + 4 * fq; const bf16_t* ue1 = XN + (rb1 + fr) * D + g * 16 + 4 * fq;
    bf16_t* yo0 = YO + (rb0 + fr) * D + g * 16 + 4 * fq; bf16_t* yo1 = YO + (rb1 + fr) * D + g * 16 + 4 * fq;
    const int nblk = L / 16;
    bf16x8 an = *(const bf16x8*)ua; u32x2 e0n = *(const u32x2*)ue0, e1n = *(const u32x2*)ue1;
    for (int blk = 0; blk < nblk; ++blk) {
        const bf16x8 af = an; const u32x2 e0 = e0n, e1 = e1n;
        if (blk + 1 < nblk) { const size_t o = (size_t)(blk + 1) * 16 * D; an = *(const bf16x8*)(ua + o); e0n = *(const u32x2*)(ue0 + o); e1n = *(const u32x2*)(ue1 + o); }
        f32x16 z;
#pragma unroll
        for (int i = 0; i < 16; ++i) z[i] = 0.f;
        f32x16 bre0 = __builtin_amdgcn_mfma_f32_32x32x16_bf16(af, bfr[0], z, 0, 0, 0);
        f32x16 bre1 = __builtin_amdgcn_mfma_f32_32x32x16_bf16(af, bfr[1], z, 0, 0, 0);
        f32x16 bim0 = __builtin_amdgcn_mfma_f32_32x32x16_bf16(af, bfr[2], z, 0, 0, 0);
        f32x16 bim1 = __builtin_amdgcn_mfma_f32_32x32x16_bf16(af, bfr[3], z, 0, 0, 0);
#pragma unroll
        for (int i = 0; i < 16; ++i) {
            const float nr0 = ar0 * hr0 - ai0 * hi0 + bre0[i], ni0 = ar0 * hi0 + ai0 * hr0 + bim0[i];
            const float nr1 = ar1 * hr1 - ai1 * hi1 + bre1[i], ni1 = ar1 * hi1 + ai1 * hr1 + bim1[i];
            hr0 = nr0; hi0 = ni0; hr1 = nr1; hi1 = ni1;
            u32x2 w; w.x = pk_bf16(hr0, hi0); w.y = pk_bf16(hr1, hi1);
            *(u32x2*)(wl + (hh * 16 + i) * 272 + n * 8) = w;
        }
        f32x4 y0 = {0.f, 0.f, 0.f, 0.f}, y1 = {0.f, 0.f, 0.f, 0.f};
#pragma unroll
        for (int ks = 0; ks < 4; ++ks) {
            const bf16x8 h0 = *(const bf16x8*)(wl + fr * 272 + (32 * ks + 8 * fq) * 2);
            const bf16x8 h1 = *(const bf16x8*)(wl + (16 + fr) * 272 + (32 * ks + 8 * fq) * 2);
            y0 = __builtin_amdgcn_mfma_f32_16x16x32_bf16(cf[ks], h0, y0, 0, 0, 0);
            y1 = __builtin_amdgcn_mfma_f32_16x16x32_bf16(cf[ks], h1, y1, 0, 0, 0);
        }
        {
            const float u0[4] = {bf_lo(e0.x), bf_hi(e0.x), bf_lo(e0.y), bf_hi(e0.y)}, u1[4] = {bf_lo(e1.x), bf_hi(e1.x), bf_lo(e1.y), bf_hi(e1.y)};
            float a[4], b[4];
#pragma unroll
            for (int j = 0; j < 4; ++j) { a[j] = gelu_tanh(y0[j] + d4[j] * u0[j]); b[j] = gelu_tanh(y1[j] + d4[j] * u1[j]); }
            u32x2 w0, w1; w0.x = pk_bf16(a[0], a[1]); w0.y = pk_bf16(a[2], a[3]); w1.x = pk_bf16(b[0], b[1]); w1.y = pk_bf16(b[2], b[3]);
            const size_t o = (size_t)blk * 16 * D;
            *(u32x2*)(yo0 + o) = w0; *(u32x2*)(yo1 + o) = w1;
        }
    }
    {
        const size_t si = ((size_t)(l * 8 + seqh) * 64 + g) * 64 + n;
        float* ore = P.out + (prompt ? O_SRP : O_SRS); float* oim = P.out + (prompt ? O_SIP : O_SIS);
        ore[si] = hr0; oim[si] = hi0; ore[si + 32] = hr1; oim[si + 32] = hi1;
    }
}

DI void s5_phase(const Params& P, unsigned char* lds, int l) {
    const int tid = otid(), wid = __builtin_amdgcn_readfirstlane(tid >> 6), lane = tid & 63;
    const int n = lane & 31, hh = lane >> 5, fr = lane & 15, fq = lane >> 4;
    const bf16_t* XN = (const bf16_t*)(P.ws + OFF_XN);
    bf16_t* YO = (bf16_t*)(P.ws + OFF_QB);
    const bool prompt = wid < 4, active = true;
    const int role = wid & 3;
    const bool roleA = role < 2;
    unsigned char* hbuf = lds + (prompt ? 0 : 17408);
    for (int it = obid(); it < 256; it += gridDim.x) {
        const int pair = it >> 6, g = it & 63;
        const int nblk = prompt ? SEQ / 16 : 1;
        const size_t rb0 = prompt ? (size_t)(pair * 2) * SEQ : (size_t)NP + (size_t)(pair * 2) * 16;
        const size_t rb1 = prompt ? rb0 + SEQ : rb0 + 16;
        float ar = 0.f, ai = 0.f, hr = 0.f, hi = 0.f;
        bf16x8 frag[4]; bf16x8 an; const bf16_t* ua = XN;
        const int seqh = pair * 2 + hh, pst = 32 * (role & 1) + n;
        f32x4 d4 = {0.f, 0.f, 0.f, 0.f}; u32x2 e0n; const bf16_t* ue0 = XN; bf16_t* yo0 = YO; const int bs = role & 1;
#pragma unroll
        for (int k = 0; k < 4; ++k) frag[k] = (bf16x8){0, 0, 0, 0, 0, 0, 0, 0};
        an = (bf16x8){0, 0, 0, 0, 0, 0, 0, 0}; e0n = (u32x2){0u, 0u};
        bf16x8 an1 = an, an2 = an, an3 = an; u32x2 e1q = e0n, e2q = e0n, e3q = e0n;
        if (active && roleA) {
            float crf, cif;
            s5_consts(P, l, g, pst, ar, ai, crf, cif);
            const int gp = (l * 64 + g) * 64 + pst;
            const float* br = P.in[14] + (size_t)gp * 16 + 8 * hh; const float* bi = P.in[15] + (size_t)gp * 16 + 8 * hh;
            const f32x4 r0 = *(const f32x4*)br, r1 = *(const f32x4*)(br + 4), i0 = *(const f32x4*)bi, i1 = *(const f32x4*)(bi + 4);
            u32x4 wr, wi;
            wr.x = pk_bf16(crf * r0[0] - cif * i0[0], crf * r0[1] - cif * i0[1]); wr.y = pk_bf16(crf * r0[2] - cif * i0[2], crf * r0[3] - cif * i0[3]);
            wr.z = pk_bf16(crf * r1[0] - cif * i1[0], crf * r1[1] - cif * i1[1]); wr.w = pk_bf16(crf * r1[2] - cif * i1[2], crf * r1[3] - cif * i1[3]);
            wi.x = pk_bf16(crf * i0[0] + cif * r0[0], crf * i0[1] + cif * r0[1]); wi.y = pk_bf16(crf * i0[2] + cif * r0[2], crf * i0[3] + cif * r0[3]);
            wi.z = pk_bf16(crf * i1[0] + cif * r1[0], crf * i1[1] + cif * r1[1]); wi.w = pk_bf16(crf * i1[2] + cif * r1[2], crf * i1[3] + cif * r1[3]);
            frag[0] = __builtin_bit_cast(bf16x8, wr); frag[1] = __builtin_bit_cast(bf16x8, wi);
            if (!prompt) { const size_t si = ((size_t)(l * 8 + seqh) * 64 + g) * 64 + pst; hr = P.in[2][si]; hi = P.in[3][si]; }
            const int sm = (n >> 2) & 1, im = (n & 3) + 4 * (n >> 3);
            ua = XN + ((sm ? rb1 : rb0) + im) * D + g * 16 + 8 * hh;
            an = *(const bf16x8*)ua;
            if (nblk > 1) an1 = *(const bf16x8*)(ua + (size_t)1 * 16 * D);
            if (nblk > 2) an2 = *(const bf16x8*)(ua + (size_t)2 * 16 * D);
            if (nblk > 3) an3 = *(const bf16x8*)(ua + (size_t)3 * 16 * D);
        }
        if (active && !roleA) {
            const float* cr = P.in[16] + ((size_t)(l * 64 + g) * 16 + fr) * 64; const float* ci = P.in[17] + ((size_t)(l * 64 + g) * 16 + fr) * 64;
#pragma unroll
            for (int ks = 0; ks < 4; ++ks) {
                const int n0 = 8 * ks + 2 * fq;
                const f32x2 ra = *(const f32x2*)(cr + n0), rb = *(const f32x2*)(cr + 32 + n0), ia = *(const f32x2*)(ci + n0), ib = *(const f32x2*)(ci + 32 + n0);
                u32x4 w; w.x = pk_bf16(ra.x, -ia.x); w.y = pk_bf16(rb.x, -ib.x); w.z = pk_bf16(ra.y, -ia.y); w.w = pk_bf16(rb.y, -ib.y);
                frag[ks] = __builtin_bit_cast(bf16x8, w);
            }
            d4 = *(const f32x4*)(P.in[18] + (size_t)l * D + g * 16 + 4 * fq);
            ue0 = XN + ((bs ? rb1 : rb0) + fr) * D + g * 16 + 4 * fq;
            yo0 = YO + ((bs ? rb1 : rb0) + fr) * D + g * 16 + 4 * fq;
            e0n = *(const u32x2*)ue0;
            if (nblk > 1) e1q = *(const u32x2*)(ue0 + (size_t)1 * 16 * D);
            if (nblk > 2) e2q = *(const u32x2*)(ue0 + (size_t)2 * 16 * D);
            if (nblk > 3) e3q = *(const u32x2*)(ue0 + (size_t)3 * 16 * D);
        }
        const int nsteps = SEQ / 16 + 4;
#define S5_BARRIER() do { asm volatile("s_waitcnt lgkmcnt(0)" ::: "memory"); __builtin_amdgcn_s_barrier(); asm volatile("" ::: "memory"); } while (0)
#define S5_A(step, ANQ) do { \
            const bf16x8 af = ANQ; \
            { const int nb_ = (step) + 4 < nblk ? (step) + 4 : nblk - 1; ANQ = *(const bf16x8*)(ua + (size_t)nb_ * 16 * D); } \
            if ((step) < nblk) { \
                f32x16 z; \
                _Pragma("unroll") for (int i = 0; i < 16; ++i) z[i] = 0.f; \
                const f32x16 bre = __builtin_amdgcn_mfma_f32_32x32x16_bf16(af, frag[0], z, 0, 0, 0); \
                const f32x16 bim = __builtin_amdgcn_mfma_f32_32x32x16_bf16(af, frag[1], z, 0, 0, 0); \
                unsigned char* wl = hbuf + ((step) & 1) * 8704 + (role & 1) * 4; \
                _Pragma("unroll") for (int i = 0; i < 16; ++i) { \
                    float t1 = __builtin_fmaf(-ai, hi, bre[i]), t2 = __builtin_fmaf(ai, hr, bim[i]); \
                    asm volatile("" : "+v"(t1), "+v"(t2));     \
                    float nr = __builtin_fmaf(ar, hr, t1), ni = __builtin_fmaf(ar, hi, t2); \
                    asm volatile("" : "+v"(nr), "+v"(ni)); \
                    hr = nr; hi = ni; \
                    *(unsigned*)(wl + (hh * 16 + i) * 272 + n * 8) = pk_bf16(hr, hi); \
                } \
            } \
            S5_BARRIER(); \
        } while (0)
#define S5_B(step, EQ) do { \
            const int blk = (step) - 1; \
            const u32x2 e0 = EQ; \
            { const int nb_ = blk + 4 < nblk ? (blk + 4 > 0 ? blk + 4 : 0) : nblk - 1; EQ = *(const u32x2*)(ue0 + (size_t)nb_ * 16 * D); } \
            if ((step) >= 1 && (step) <= nblk) { \
                const unsigned char* wl = hbuf + (blk & 1) * 8704 + bs * 16 * 272; \
                f32x4 y0 = {0.f, 0.f, 0.f, 0.f}, y1 = {0.f, 0.f, 0.f, 0.f}; \
                { \
                    const bf16x8 h0 = *(const bf16x8*)(wl + fr * 272 + (8 * fq) * 2), h1 = *(const bf16x8*)(wl + fr * 272 + (32 + 8 * fq) * 2); \
                    const bf16x8 h2 = *(const bf16x8*)(wl + fr * 272 + (64 + 8 * fq) * 2), h3 = *(const bf16x8*)(wl + fr * 272 + (96 + 8 * fq) * 2); \
                    y0 = __builtin_amdgcn_mfma_f32_16x16x32_bf16(frag[0], h0, y0, 0, 0, 0); \
                    y1 = __builtin_amdgcn_mfma_f32_16x16x32_bf16(frag[1], h1, y1, 0, 0, 0); \
                    y0 = __builtin_amdgcn_mfma_f32_16x16x32_bf16(frag[2], h2, y0, 0, 0, 0); \
                    y1 = __builtin_amdgcn_mfma_f32_16x16x32_bf16(frag[3], h3, y1, 0, 0, 0); \
                } \
                const float u0[4] = {bf_lo(e0.x), bf_hi(e0.x), bf_lo(e0.y), bf_hi(e0.y)}; \
                float a[4]; \
                _Pragma("unroll") for (int j = 0; j < 4; ++j) a[j] = gelu_tanh((y0[j] + y1[j]) + d4[j] * u0[j]); \
                u32x2 w0; w0.x = pk_bf16(a[0], a[1]); w0.y = pk_bf16(a[2], a[3]); \
                *(u32x2*)(yo0 + (size_t)blk * 16 * D) = w0; \
            } \
            S5_BARRIER(); \
        } while (0)
        if (roleA) {
            for (int step = 0; step < nsteps; step += 4) { S5_A(step, an); S5_A(step + 1, an1); S5_A(step + 2, an2); S5_A(step + 3, an3); }
        } else {
            for (int step = 0; step < nsteps; step += 4) { S5_B(step, e3q); S5_B(step + 1, e0n); S5_B(step + 2, e1q); S5_B(step + 3, e2q); }
        }
#undef S5_A
#undef S5_B
#undef S5_BARRIER
        if (active && roleA) {
            const size_t si = ((size_t)(l * 8 + seqh) * 64 + g) * 64 + pst;
            float* ore = P.out + (prompt ? O_SRP : O_SRS); float* oim = P.out + (prompt ? O_SIP : O_SIS);
            ore[si] = hr; oim[si] = hi;
        }
    }
}

constexpr int LDS_TAB = 0, LDS_QS = 16512, LDS_S = LDS_QS + 4096, S_PITCH = 532;
constexpr float SCALE = 0.125f;

struct KVChunk { bf16x8 k[2][4]; u32x4 v[2][2][2]; };
DI void load_chunk(KVChunk& C, const bf16_t* kp, const bf16_t* vb0, const bf16_t* vb1) {
#pragma unroll
    for (int t = 0; t < 2; ++t) {
#pragma unroll
        for (int ks = 0; ks < 4; ++ks) C.k[t][ks] = *(const bf16x8*)(kp + (size_t)t * 32 * D + 16 * ks);
#pragma unroll
        for (int s = 0; s < 2; ++s) {
            C.v[t][0][s] = *(const u32x4*)(vb0 + t * 32 + 16 * s);
            C.v[t][1][s] = *(const u32x4*)(vb1 + t * 32 + 16 * s);
        }
    }
}
DI void attn_prompt_item(const Params& P, const float* tab  , int n, int c, int hd, int qh) {
    const int lane = otid() & 63, r = lane & 31, hh = lane >> 5;
    const bf16_t* QB = (const bf16_t*)(P.ws + OFF_QB);
    const bf16_t* KB = (const bf16_t*)(P.ws + OFF_KB);
    const bf16_t* VT = (const bf16_t*)(P.ws + OFF_VT);
    const int qrow = n * SEQ + c * 64 + qh * 32 + r;
    bf16x8 qf[4];
#pragma unroll
    for (int ks = 0; ks < 4; ++ks) qf[ks] = *(const bf16x8*)(QB + (size_t)qrow * D + hd * 64 + 16 * ks + 8 * hh);
    f32x16 o0, o1;
#pragma unroll
    for (int i = 0; i < 16; ++i) { o0[i] = 0.f; o1[i] = 0.f; }
    float m = -1e30f, lsum = 0.f;
    const float* trow = tab + hd * 257;
    const bf16_t* kbase = KB + (size_t)(n * SEQ + r) * D + hd * 64 + 8 * hh;
    const bf16_t* vbase0 = VT + ((size_t)(n * 16 + hd) * 64 + r) * SEQ + 8 * hh;
    const bf16_t* vbase1 = vbase0 + (size_t)32 * SEQ;
    const int kc0 = c > 8 ? c - 8 : 0;
    KVChunk A, B;
    load_chunk(A, kbase + (size_t)kc0 * 64 * D, vbase0 + kc0 * 64, vbase1 + kc0 * 64);
    for (int kc = kc0; kc <= c; ++kc) {
        if (kc < c) load_chunk(B, kbase + (size_t)(kc + 1) * 64 * D, vbase0 + (kc + 1) * 64, vbase1 + (kc + 1) * 64);
#pragma unroll
        for (int t = 0; t < 2; ++t) {
            const int kpos0 = kc * 64 + t * 32;
            f32x16 sa;
#pragma unroll
            for (int i = 0; i < 16; ++i) sa[i] = 0.f;
#pragma unroll
            for (int ks = 0; ks < 4; ++ks) sa = __builtin_amdgcn_mfma_f32_32x32x16_bf16(A.k[t][ks], qf[ks], sa, 0, 0, 0);
            const int dbase = (c * 64 + qh * 32 + r) - kpos0 - 4 * hh;
            const int dmin = (c * 64 + qh * 32) - kpos0 - 31;
            float sc[16]; float tmax = -1e30f;
            if (dmin >= 128) {
                const float bconst = trow[256];
#pragma unroll
                for (int i = 0; i < 16; ++i) { sc[i] = sa[i] * (SCALE * LOG2E) + bconst; tmax = fmaxf(tmax, sc[i]); }
            } else {
#pragma unroll
                for (int i = 0; i < 16; ++i) {
                    int rel = dbase - ((i & 3) + 8 * (i >> 2));
                    rel = rel < -128 ? -128 : (rel > 128 ? 128 : rel);
                    sc[i] = sa[i] * (SCALE * LOG2E) + trow[rel + 128]; tmax = fmaxf(tmax, sc[i]);
                }
            }
            tmax = fmaxf(tmax, __shfl_xor(tmax, 32));
            const float mn = fmaxf(m, tmax), alpha = fast_exp2(m - mn);
            const bool resc = __builtin_amdgcn_ballot_w64(mn > m) != 0ull;
            m = mn;
            float ps = 0.f;
#pragma unroll
            for (int i = 0; i < 16; ++i) { sc[i] = fast_exp2(sc[i] - mn); ps += sc[i]; }
            lsum = lsum * alpha + ps;
            if (resc) {
#pragma unroll
                for (int i = 0; i < 16; ++i) { o0[i] *= alpha; o1[i] *= alpha; }
            }
#pragma unroll
            for (int s = 0; s < 2; ++s) {
                u32x4 pw; pw.x = pk_bf16(sc[8 * s + 0], sc[8 * s + 1]); pw.y = pk_bf16(sc[8 * s + 2], sc[8 * s + 3]); pw.z = pk_bf16(sc[8 * s + 4], sc[8 * s + 5]); pw.w = pk_bf16(sc[8 * s + 6], sc[8 * s + 7]);
                const bf16x8 pf = __builtin_bit_cast(bf16x8, pw);
                o0 = __builtin_amdgcn_mfma_f32_32x32x16_bf16(__builtin_bit_cast(bf16x8, A.v[t][0][s]), pf, o0, 0, 0, 0);
                o1 = __builtin_amdgcn_mfma_f32_32x32x16_bf16(__builtin_bit_cast(bf16x8, A.v[t][1][s]), pf, o1, 0, 0, 0);
            }
        }
        A = B;
    }
    lsum += __shfl_xor(lsum, 32);
    const float inv = fast_rcp(lsum);
    bf16_t* op = (bf16_t*)(P.ws + OFF_XN) + (size_t)qrow * D + hd * 64 + 4 * hh;
#pragma unroll
    for (int g4 = 0; g4 < 4; ++g4) {
        u32x2 w; w.x = pk_bf16(o0[4 * g4] * inv, o0[4 * g4 + 1] * inv); w.y = pk_bf16(o0[4 * g4 + 2] * inv, o0[4 * g4 + 3] * inv);
        *(u32x2*)(op + 8 * g4) = w;
        u32x2 z; z.x = pk_bf16(o1[4 * g4] * inv, o1[4 * g4 + 1] * inv); z.y = pk_bf16(o1[4 * g4 + 2] * inv, o1[4 * g4 + 3] * inv);
        *(u32x2*)(op + 32 + 8 * g4) = z;
    }
}

struct KVTile { bf16x8 k[4]; u32x4 v[2][2]; };
DI void load_tile(KVTile& T, const bf16_t* kp, const bf16_t* vb0, const bf16_t* vb1) {
#pragma unroll
    for (int ks = 0; ks < 4; ++ks) T.k[ks] = *(const bf16x8*)(kp + 16 * ks);
#pragma unroll
    for (int s = 0; s < 2; ++s) { T.v[0][s] = *(const u32x4*)(vb0 + 16 * s); T.v[1][s] = *(const u32x4*)(vb1 + 16 * s); }
}
DI void attn_prompt_item64(const Params& P, const float* tab, int n, int c, int hd) {
    const int lane = otid() & 63, r = lane & 31, hh = lane >> 5;
    const bf16_t* QB = (const bf16_t*)(P.ws + OFF_QB);
    const bf16_t* KB = (const bf16_t*)(P.ws + OFF_KB);
    const bf16_t* VT = (const bf16_t*)(P.ws + OFF_VT);
    const int qrow = n * SEQ + c * 64 + r;
    bf16x8 qf[2][4];
#pragma unroll
    for (int qh = 0; qh < 2; ++qh)
#pragma unroll
        for (int ks = 0; ks < 4; ++ks) qf[qh][ks] = *(const bf16x8*)(QB + (size_t)(qrow + 32 * qh) * D + hd * 64 + 16 * ks + 8 * hh);
    f32x16 o[2][2];
#pragma unroll
    for (int i = 0; i < 16; ++i) { o[0][0][i] = 0.f; o[0][1][i] = 0.f; o[1][0][i] = 0.f; o[1][1][i] = 0.f; }
    float m[2] = {-1e30f, -1e30f}, lsum[2] = {0.f, 0.f};
    const float* trow = tab + hd * 257;
    const bf16_t* kbase = KB + (size_t)(n * SEQ + r) * D + hd * 64 + 8 * hh;
    const bf16_t* vbase0 = VT + ((size_t)(n * 16 + hd) * 64 + r) * SEQ + 8 * hh;
    const bf16_t* vbase1 = vbase0 + (size_t)32 * SEQ;
    const int kt0 = (c > 8 ? c - 8 : 0) * 2, kt1 = (c + 1) * 2;
    KVTile A, B;
    load_tile(A, kbase + (size_t)kt0 * 32 * D, vbase0 + kt0 * 32, vbase1 + kt0 * 32);
    for (int kt = kt0; kt < kt1; ++kt) {
        if (kt + 1 < kt1) load_tile(B, kbase + (size_t)(kt + 1) * 32 * D, vbase0 + (kt + 1) * 32, vbase1 + (kt + 1) * 32);
        const int kpos0 = kt * 32;
#pragma unroll
        for (int qh = 0; qh < 2; ++qh) {
            f32x16 sa;
#pragma unroll
            for (int i = 0; i < 16; ++i) sa[i] = 0.f;
#pragma unroll
            for (int ks = 0; ks < 4; ++ks) sa = __builtin_amdgcn_mfma_f32_32x32x16_bf16(A.k[ks], qf[qh][ks], sa, 0, 0, 0);
            const int dbase = (c * 64 + qh * 32 + r) - kpos0 - 4 * hh;
            const int dmin = (c * 64 + qh * 32) - kpos0 - 31;
            float sc[16]; float tmax = -1e30f;
            if (dmin >= 128) {
                const float bconst = trow[256];
#pragma unroll
                for (int i = 0; i < 16; ++i) { sc[i] = sa[i] * (SCALE * LOG2E) + bconst; tmax = fmaxf(tmax, sc[i]); }
            } else {
#pragma unroll
                for (int i = 0; i < 16; ++i) {
                    int rel = dbase - ((i & 3) + 8 * (i >> 2));
                    rel = rel < -128 ? -128 : (rel > 128 ? 128 : rel);
                    sc[i] = sa[i] * (SCALE * LOG2E) + trow[rel + 128]; tmax = fmaxf(tmax, sc[i]);
                }
            }
            tmax = fmaxf(tmax, __shfl_xor(tmax, 32));
            const float mn = fmaxf(m[qh], tmax), alpha = fast_exp2(m[qh] - mn);
            const bool resc = __builtin_amdgcn_ballot_w64(mn > m[qh]) != 0ull;
            m[qh] = mn;
            float ps = 0.f;
#pragma unroll
            for (int i = 0; i < 16; ++i) { sc[i] = fast_exp2(sc[i] - mn); ps += sc[i]; }
            lsum[qh] = lsum[qh] * alpha + ps;
            if (resc) {
#pragma unroll
                for (int i = 0; i < 16; ++i) { o[qh][0][i] *= alpha; o[qh][1][i] *= alpha; }
            }
#pragma unroll
            for (int s = 0; s < 2; ++s) {
                u32x4 pw; pw.x = pk_bf16(sc[8 * s + 0], sc[8 * s + 1]); pw.y = pk_bf16(sc[8 * s + 2], sc[8 * s + 3]); pw.z = pk_bf16(sc[8 * s + 4], sc[8 * s + 5]); pw.w = pk_bf16(sc[8 * s + 6], sc[8 * s + 7]);
                const bf16x8 pf = __builtin_bit_cast(bf16x8, pw);
                o[qh][0] = __builtin_amdgcn_mfma_f32_32x32x16_bf16(__builtin_bit_cast(bf16x8, A.v[0][s]), pf, o[qh][0], 0, 0, 0);
                o[qh][1] = __builtin_amdgcn_mfma_f32_32x32x16_bf16(__builtin_bit_cast(bf16x8, A.v[1][s]), pf, o[qh][1], 0, 0, 0);
            }
        }
        A = B;
    }
#pragma unroll
    for (int qh = 0; qh < 2; ++qh) {
        const float lt = lsum[qh] + __shfl_xor(lsum[qh], 32);
        const float inv = fast_rcp(lt);
        bf16_t* op = (bf16_t*)(P.ws + OFF_XN) + (size_t)(qrow + 32 * qh) * D + hd * 64 + 4 * hh;
#pragma unroll
        for (int g4 = 0; g4 < 4; ++g4) {
            u32x2 w; w.x = pk_bf16(o[qh][0][4 * g4] * inv, o[qh][0][4 * g4 + 1] * inv); w.y = pk_bf16(o[qh][0][4 * g4 + 2] * inv, o[qh][0][4 * g4 + 3] * inv);
            *(u32x2*)(op + 8 * g4) = w;
            u32x2 z; z.x = pk_bf16(o[qh][1][4 * g4] * inv, o[qh][1][4 * g4 + 1] * inv); z.y = pk_bf16(o[qh][1][4 * g4 + 2] * inv, o[qh][1][4 * g4 + 3] * inv);
            *(u32x2*)(op + 32 + 8 * g4) = z;
        }
    }
}

constexpr int LDS_RED = 57344;
DI void attn_sample_item(const Params& P, unsigned char* lds, int nb, int hd) {
    const int tid = otid(), wid = tid >> 6, lane = tid & 63;
    const float* tab = (const float*)(lds + LDS_TAB) + hd * 257;
    float* qs = (float*)(lds + LDS_QS);
    float* S = (float*)(lds + LDS_S);
    f32x2* red = (f32x2*)(lds + LDS_RED);
    const bf16_t* QB = (const bf16_t*)(P.ws + OFF_QB);
    for (int e = tid; e < 1024; e += 512) { const int qi = e >> 6, d = e & 63; qs[e] = __uint_as_float((unsigned)QB[(size_t)(NP + nb * 16 + qi) * D + hd * 64 + d] << 16) * (SCALE * LOG2E); }
    __syncthreads();
    for (int j = tid; j < 528; j += 512) {
        const float* kp = j < 512 ? P.in[4] + ((size_t)(nb * 512 + j) * 16 + hd) * 64 : P.out + O_KS + (size_t)(nb * 16 + (j - 512)) * D + hd * 64;
        float acc[16];
#pragma unroll
        for (int qi = 0; qi < 16; ++qi) acc[qi] = 0.f;
#pragma unroll 2
        for (int d4 = 0; d4 < 16; ++d4) {
            const f32x4 k4 = *(const f32x4*)(kp + 4 * d4);
#pragma unroll
            for (int qi = 0; qi < 16; ++qi) { const f32x4 q4 = *(const f32x4*)(qs + qi * 64 + 4 * d4); acc[qi] += k4[0] * q4[0] + k4[1] * q4[1] + k4[2] * q4[2] + k4[3] * q4[3]; }
        }
        const int kpos = j < 512 ? 3584 + j : 4096 + (j - 512);
#pragma unroll
        for (int qi = 0; qi < 16; ++qi) {
            int rel = (4096 + qi) - kpos; rel = rel < -128 ? -128 : (rel > 128 ? 128 : rel);
            S[qi * S_PITCH + j] = acc[qi] + tab[rel + 128];
        }
    }
    __syncthreads();
#pragma unroll
    for (int qq = 0; qq < 2; ++qq) {
        const int qi = wid * 2 + qq;
        float mx = -1e30f;
        for (int j = lane; j < 528; j += 64) mx = fmaxf(mx, S[qi * S_PITCH + j]);
        mx = wave_max(mx);
        float sm = 0.f;
        for (int j = lane; j < 528; j += 64) { const float e = fast_exp2(S[qi * S_PITCH + j] - mx); S[qi * S_PITCH + j] = e; sm += e; }
        sm = wave_sum(sm);
        const float inv = 1.0f / sm;
        for (int j = lane; j < 528; j += 64) S[qi * S_PITCH + j] *= inv;
    }
    __syncthreads();
    {
        const int sl = tid >> 5, l32 = tid & 31, dd = l32 * 2;
        f32x2 acc[16];
#pragma unroll
        for (int qi = 0; qi < 16; ++qi) acc[qi] = (f32x2){0.f, 0.f};
        const float* vc = P.in[5] + ((size_t)(nb * 512 + sl * 32) * 16 + hd) * 64 + dd;
#pragma unroll 8
        for (int jj = 0; jj < 32; ++jj) {
            const f32x2 v = *(const f32x2*)(vc + (size_t)jj * D);
#pragma unroll
            for (int qi = 0; qi < 16; ++qi) acc[qi] += v * S[qi * S_PITCH + sl * 32 + jj];
        }
        {
            const f32x2 v = *(const f32x2*)(P.out + O_VS + (size_t)(nb * 16 + sl) * D + hd * 64 + dd);
#pragma unroll
            for (int qi = 0; qi < 16; ++qi) acc[qi] += v * S[qi * S_PITCH + 512 + sl];
        }
#pragma unroll
        for (int qi = 0; qi < 16; ++qi) red[(sl * 16 + qi) * 32 + l32] = acc[qi];
    }
    __syncthreads();
    {
        const int qi = tid >> 5, l32 = tid & 31;
        f32x2 a = {0.f, 0.f};
#pragma unroll
        for (int sl = 0; sl < 16; ++sl) a += red[(sl * 16 + qi) * 32 + l32];
        *(unsigned*)((bf16_t*)(P.ws + OFF_XN) + (size_t)(NP + nb * 16 + qi) * D + hd * 64 + l32 * 2) = pk_bf16(a.x, a.y);
    }
    __syncthreads();
}

DI void attn_phase(const Params& P, unsigned char* lds, int b) {
    const int tid = otid(), wid = __builtin_amdgcn_readfirstlane(tid >> 6);
    float* tab = (float*)(lds + LDS_TAB);
    for (int e = tid; e < 16 * 257; e += 512) tab[e] = P.in[24][(size_t)b * 16 * 257 + e] * LOG2E;
    __syncthreads();
    if (ATTN_Q64) {
        for (int id = obid() * 8 + wid; id < 2048; id += (int)gridDim.x * 8) {
            const int hd = id & 15, cp = (id >> 4) & 15, n = id >> 8;
            attn_prompt_item64(P, tab, n, 31 - cp, hd);
            attn_prompt_item64(P, tab, n, cp, hd);
        }
        __syncthreads();
        if (gridDim.x == 256) { const int bid = obid(), cp = (bid >> 1) & 15; if (cp < 8) { const int it = (bid >> 5) * 16 + cp * 2 + (bid & 1); attn_sample_item(P, lds, it >> 4, it & 15); } }
        else { for (int it = (int)gridDim.x - 1 - obid(); it < 128; it += (int)gridDim.x) attn_sample_item(P, lds, it >> 4, it & 15); }
        return;
    }
    for (int it = (int)gridDim.x - 1 - obid(); it < 128; it += (int)gridDim.x) attn_sample_item(P, lds, it >> 4, it & 15);
    if (false) {
    } else if (ATTN_XCD_MAP && gridDim.x == 256) {
        const int bid = obid(), n = bid & 7, j = bid >> 3;
        for (int k = 0; k < 4; ++k) attn_prompt_item(P, tab, n, j, k * 4 + (wid >> 1), wid & 1);
    } else {
        for (int it = obid() * 8 + wid; it < 8192; it += (int)gridDim.x * 8) {
            const int qh = it & 1, hd = (it >> 1) & 15, n = it >> 10, c = (((it >> 5) & 31) + 8 * (n >> 1)) & 31;
            attn_prompt_item(P, tab, n, c, hd, qh);
        }
    }
}

#define XB_TMO      128
#define XB_XCNT(j)  (256  + 64 * (j))
#define XB_XSUB(j)  (1280 + 64 * (j))
#define XB_XGEN(j)  (2304 + 64 * (j))
#define XB_TOP      3328
#define XB_TOPGEN   3392
#define XCD_BAR_WORDS 3456
#define XB_SPIN_CAP (1u << 18)
DI unsigned xb_ld(unsigned* p)              { return __hip_atomic_load(p, __ATOMIC_RELAXED, __HIP_MEMORY_SCOPE_AGENT); }
DI unsigned xb_add(unsigned* p, unsigned v) { return __hip_atomic_fetch_add(p, v, __ATOMIC_RELAXED, __HIP_MEMORY_SCOPE_AGENT); }
DI unsigned xb_xcc_id() { return (unsigned)__builtin_amdgcn_s_getreg((3 << 11) | 20) & 0xFu; }
#define XB_SPIN(cond, bar) do { unsigned _sp = 0; while (cond) { __builtin_amdgcn_s_sleep(1); \
    if ((++_sp & 255u) == 0u) { if (xb_ld(&(bar)[XB_TMO])) break; if (_sp > XB_SPIN_CAP) { atomicAdd(&(bar)[XB_TMO], 1u); break; } } } } while (0)
struct XcdBarrier { unsigned* bar; unsigned x; volatile LAS unsigned* st; };
DI XcdBarrier xcd_barrier_post(unsigned* bar, volatile LAS unsigned* st) {
    XcdBarrier b; b.bar = bar; b.x = xb_xcc_id(); b.st = st;
    if (threadIdx.x == 0) (void)xb_add(&bar[XB_XCNT(b.x)], 1u);
    return b;
}
DI void xcd_barrier_complete(unsigned* bar, unsigned x, unsigned& nloc, unsigned& nx) {
    const unsigned G = gridDim.x * gridDim.y * gridDim.z;
    unsigned sum, cnt, mine, sp = 0u;
    for (;;) {
        sum = 0u; cnt = 0u; mine = 0u;
#pragma unroll
        for (unsigned j = 0; j < 16; ++j) { const unsigned c = xb_ld(&bar[XB_XCNT(j)]); sum += c; cnt += (c > 0u) ? 1u : 0u; mine = (j == x) ? c : mine; }
        if (sum == G) break;
        __builtin_amdgcn_s_sleep(1);
        if ((++sp & 255u) == 0u) { if (xb_ld(&bar[XB_TMO])) break; if (sp > XB_SPIN_CAP) { atomicAdd(&bar[XB_TMO], 1u); break; } }
    }
    nloc = mine > 0u ? mine : 1u; nx = cnt > 0u ? cnt : 1u;
}
DI void xcd_barrier(const XcdBarrier& b) {
    asm volatile("s_waitcnt vmcnt(0)" ::: "memory");
    __syncthreads();
    if (threadIdx.x == 0) {
        unsigned* bar = b.bar;
        __builtin_amdgcn_s_waitcnt(0);
        unsigned nloc = b.st[0], nx = b.st[1];
        if (nloc == 0u) { xcd_barrier_complete(bar, b.x, nloc, nx); b.st[0] = nloc; b.st[1] = nx; }
        const unsigned old = xb_add(&bar[XB_XSUB(b.x)], 1u);
        const unsigned gen = old / nloc;
        if (old + 1u == (gen + 1u) * nloc) {
            __builtin_amdgcn_fence(__ATOMIC_RELEASE, "agent");
            asm volatile("s_waitcnt vmcnt(0)" ::: "memory");
            const unsigned og = xb_add(&bar[XB_TOP], 1u);
            const unsigned tg = og / nx;
            if (og + 1u == (tg + 1u) * nx) xb_add(&bar[XB_TOPGEN], 1u);
            else XB_SPIN(xb_ld(&bar[XB_TOPGEN]) == tg, bar);
            __builtin_amdgcn_fence(__ATOMIC_ACQUIRE, "agent");
            xb_add(&bar[XB_XGEN(b.x)], 1u);
            asm volatile("s_waitcnt vmcnt(0)" ::: "memory");
        } else {
            XB_SPIN(xb_ld(&bar[XB_XGEN(b.x)]) == gen, bar);
            __builtin_amdgcn_fence(__ATOMIC_ACQUIRE, "agent");
            asm volatile("s_waitcnt vmcnt(0)" ::: "memory");
        }
    }
    __syncthreads();
}

__host__ __device__ inline bool phase_empty(int ph) {
    if (ph == 0) return false;
    const int L = (ph - 1) / 11, s = (ph - 1) % 11;
    if (s == 5 && L < 2) return true;
    if (s == 10 && L != 1) return true;
    return false;
}

template <class Epi>
DI void gemm_both(const Params& P, unsigned char* lds, const bf16_t* A, const bf16_t* Bt, int N, int K, const Epi& E, int defer_slot = -1) {
    pg8::Gemm g{A, Bt, NP, N, K}; pg8::StaticOrder S; S.init(NP, N, (int)gridDim.x, obid());
    pg8::gemm_phase<Epi>((LAS unsigned char*)lds, g, S, E);
    if (SMALL_ROWS && K == 1024) { const int rem = ((NP / 256) * (N / 256)) % (int)gridDim.x; small_gemm_rows<Epi>(A + (size_t)NP * K, Bt, N, K, E, rem); }
    else if (K == 1024) small_gemm3<Epi>(lds, A + (size_t)NP * K, Bt, N, E);
    else small_gemm<Epi>(lds, A + (size_t)NP * K, Bt, N, K, E);
    if (defer_slot >= 0) { const int rem = ((NP / 256) * (N / 256)) % (int)gridDim.x; __syncthreads(); convert_deferred(P, lds, defer_slot, rem); }
}

DI void run_phase(const Params& P, unsigned char* lds, int ph) {
    if (ph == 0) {
        convert_phase(P, lds);
        rowpass(P, nullptr, nullptr, 0.f, P.in[6], nullptr, true);
        return;
    }
    const int L = (ph - 1) / 11, s = (ph - 1) % 11;
    const float* gains = P.in[6] + (size_t)L * 6 * D;
    bf16_t* XN = (bf16_t*)(P.ws + OFF_XN);
    bf16_t* ACT = (bf16_t*)(P.ws + OFF_ACT);
    bf16_t* Y = (bf16_t*)(P.ws + OFF_Y);
    bf16_t* QB = (bf16_t*)(P.ws + OFF_QB);
    const bf16_t* WL = (const bf16_t*)(P.ws + (size_t)L * SZ_LAYER);
    switch (s) {
    case 0: { EpiSwiglu E{ACT}; gemm_both(P, lds, XN, WL, 5632, 1024, E, L < 2 ? L * 2 : (L == 2 ? 4 : -1)); } break;
    case 1: { EpiBf16 E{Y}; gemm_both(P, lds, ACT, WL + SZ_WIN / 2, 1024, 2816, E); } break;
    case 2: rowpass(P, Y, gains + 1 * D, 0.5f, gains + 2 * D, nullptr, false); break;
    case 3:
        if (L < 2) s5_phase(P, lds, L);
        else { EpiBf16 E{QB}; gemm_both(P, lds, XN, (const bf16_t*)(P.ws + OFF_WQ) + (size_t)(L - 2) * D * D, 1024, 1024, E); }
        break;
    case 4:
        if (L < 2) { EpiGlu E{Y}; gemm_both(P, lds, QB, (const bf16_t*)(P.ws + OFF_WGLU) + (size_t)L * 2048 * D, 2048, 1024, E); }
        else attn_phase(P, lds, L - 2);
        break;
    case 5: { EpiBf16 E{Y}; gemm_both(P, lds, XN, (const bf16_t*)(P.ws + OFF_WO) + (size_t)(L - 2) * D * D, 1024, 1024, E); } break;
    case 6: rowpass(P, Y, gains + 3 * D, 1.0f, gains + 4 * D, nullptr, false); break;
    case 7: { EpiSwiglu E{ACT}; gemm_both(P, lds, XN, WL + (SZ_WIN + SZ_WOUT) / 2, 5632, 1024, E, L < 2 ? L * 2 + 1 : (L == 2 ? 5 : -1)); } break;
    case 8: { EpiBf16 E{Y}; gemm_both(P, lds, ACT, WL + (2 * SZ_WIN + SZ_WOUT) / 2, 1024, 2816, E); } break;
    case 9: rowpass(P, Y, gains + 5 * D, 0.5f, L < 3 ? gains + 6 * D : nullptr, L == 1 ? P.in[20] : nullptr, false); break;
    case 10: { EpiKV E{(bf16_t*)(P.ws + OFF_KB), (bf16_t*)(P.ws + OFF_VT), P.out}; gemm_both(P, lds, QB, (const bf16_t*)(P.ws + OFF_WKV), 2048, 1024, E); } break;
    }
}

__global__ void __launch_bounds__(512, 2) yoco_fwd(Params P) {
    extern __shared__ __attribute__((aligned(16))) unsigned char lds[];
    volatile LAS unsigned* st = (volatile LAS unsigned*)((LAS unsigned char*)lds + 131072);
    if (threadIdx.x < 4) st[threadIdx.x] = 0u;
    __syncthreads();
    const bool multi = P.ph_hi - P.ph_lo > 1;
    XcdBarrier bar; bar.bar = (unsigned*)(P.ws + OFF_BAR); bar.x = 0; bar.st = st;
    if (multi) bar = xcd_barrier_post((unsigned*)(P.ws + OFF_BAR), st);
    if (P.ph_lo < 0) cg::this_grid().sync();
#define GRID_SYNC() xcd_barrier(bar)
    for (int ph = P.ph_lo; ph < P.ph_hi; ++ph) {
        if (phase_empty(ph)) continue;
        Params Q = P;
        { size_t z = 0; asm volatile("" : "+s"(z)); Q.ws = P.ws + z; Q.out = P.out + z; }
        run_phase(Q, lds, ph);
        if (REPEAT_MASK) { const int kind = ph == 0 ? 11 : (ph - 1) % 11; if ((REPEAT_MASK >> kind) & 1) { GRID_SYNC(); run_phase(Q, lds, ph); } }
        for (int e = 0; e < EXTRA_SYNCS; ++e) GRID_SYNC();
        if (ph + 1 < P.ph_hi) GRID_SYNC();
    }
}

extern "C" void kernel_launch(void* const* d_in, const int* in_sizes, int n_in, void* d_out, int out_size, void* d_ws, size_t ws_size, hipStream_t stream) {
    static int grid = 0;
    if (grid == 0) {
        int dev = 0, cus = 0, per_cu = 0;
        hipGetDevice(&dev);
        hipDeviceGetAttribute(&cus, hipDeviceAttributeMultiprocessorCount, dev);
        if (hipFuncSetAttribute((const void*)yoco_fwd, hipFuncAttributeMaxDynamicSharedMemorySize, LDS_BYTES) != hipSuccess) { fprintf(stderr, "hipFuncSetAttribute failed\n"); grid = -1; return; }
        hipOccupancyMaxActiveBlocksPerMultiprocessor(&per_cu, (const void*)yoco_fwd, 512, LDS_BYTES);
        if (per_cu < 1) per_cu = 1;
        grid = cus * per_cu;
        if (n_in != 25 || ws_size < WS_END) { fprintf(stderr, "bad n_in %d or ws %zu < %zu\n", n_in, ws_size, (size_t)WS_END); grid = -1; return; }
    }
    if (grid < 0) return;
    Params p{};
    for (int i = 0; i < 25; ++i) p.in[i] = (const float*)d_in[i];
    p.out = (float*)d_out; p.ws = (unsigned char*)d_ws;
#if MEGA
    hipMemsetAsync((char*)d_ws + OFF_BAR, 0, 16384, stream);
    p.ph_lo = 0; p.ph_hi = N_PHASES;
    void* args[] = {&p};
    hipError_t e = hipLaunchCooperativeKernel((const void*)yoco_fwd, dim3(grid), dim3(512), args, LDS_BYTES, stream);
    if (e != hipSuccess) fprintf(stderr, "cooperative launch failed: %s (grid %d)\n", hipGetErrorString(e), grid);
#else
    for (int ph = 0; ph < N_PHASES; ++ph) {
        if (phase_empty(ph)) continue;
        p.ph_lo = ph; p.ph_hi = ph + 1;
        hipLaunchKernelGGL(yoco_fwd, dim3(grid), dim3(512), LDS_BYTES, stream, p);
    }
#endif
}
```

```cpp
#include <hip/hip_runtime.h>
#include <hip/hip_cooperative_groups.h>
#include <cstdio>
namespace cg = cooperative_groups;

#ifndef MEGA
#define MEGA 1
#endif
#ifndef EXTRA_SYNCS
#define EXTRA_SYNCS 0
#endif
#ifndef ATTN_XCD_MAP
#define ATTN_XCD_MAP 0
#endif
#ifndef SMALL_ROWS
#define SMALL_ROWS 0
#endif
#ifndef EPI_TWICE
#define EPI_TWICE 0
#endif
#ifndef ATTN_Q64
#define ATTN_Q64 1
#endif
#ifndef REPEAT_MASK
#define REPEAT_MASK 0
#endif

#define LAS __attribute__((address_space(3)))
#define DI __device__ __forceinline__
typedef unsigned short bf16_t;
typedef short bf16x8 __attribute__((ext_vector_type(8)));
typedef float f32x4 __attribute__((ext_vector_type(4)));
typedef float f32x16 __attribute__((ext_vector_type(16)));
typedef float f32x2 __attribute__((ext_vector_type(2)));
typedef unsigned u32x4 __attribute__((ext_vector_type(4)));
typedef unsigned u32x2 __attribute__((ext_vector_type(2)));
typedef __bf16 bf16v2 __attribute__((ext_vector_type(2)));

constexpr int D = 1024, FF = 2816, NP = 16384, NS = 128, MALL = NP + NS, SEQ = 2048;
constexpr float EPS = 1e-6f;
constexpr float LOG2E = 1.4426950408889634f;

constexpr size_t SZ_WIN = 5632ull * 1024 * 2, SZ_WOUT = 1024ull * 2816 * 2, SZ_LAYER = 2 * (SZ_WIN + SZ_WOUT);
constexpr size_t OFF_WGLU = 4 * SZ_LAYER;
constexpr size_t OFF_WKV = OFF_WGLU + 2ull * 2048 * 1024 * 2;
constexpr size_t OFF_WQ = OFF_WKV + 2048ull * 1024 * 2;
constexpr size_t OFF_WO = OFF_WQ + 2ull * 1024 * 1024 * 2;
constexpr size_t OFF_XN = OFF_WO + 2ull * 1024 * 1024 * 2;
constexpr size_t OFF_ACT = OFF_XN + (size_t)MALL * D * 2;
constexpr size_t OFF_Y = OFF_ACT + (size_t)MALL * FF * 2;
constexpr size_t OFF_QB = OFF_Y + (size_t)MALL * D * 4;
constexpr size_t OFF_BAR = OFF_QB + (size_t)MALL * D * 2;
constexpr size_t WS_END = OFF_BAR + 16384;
constexpr size_t OFF_KB = 0;
constexpr size_t OFF_VT = SZ_LAYER;

constexpr size_t O_YS = 16777216, O_SRP = 16908288, O_SIP = 16973824, O_KP = 17039360, O_VP = 21233664,
                 O_SRS = 25427968, O_SIS = 25493504, O_KS = 25559040, O_VS = 25690112;

constexpr int LDS_BYTES = 131072 + 16;
constexpr int N_PHASES = 45;

struct Params {
    const float* in[25];
    float* out;
    unsigned char* ws;
    int ph_lo, ph_hi;
};

DI int otid() { int t = threadIdx.x; asm volatile("" : "+v"(t)); return t; }
DI int obid() { int b = blockIdx.x; asm volatile("" : "+s"(b)); return b; }
DI unsigned pk_bf16(float lo, float hi) { f32x2 v = {lo, hi}; bf16v2 b = __builtin_convertvector(v, bf16v2); return __builtin_bit_cast(unsigned, b); }
DI float bf_lo(unsigned u) { return __uint_as_float(u << 16); }
DI float bf_hi(unsigned u) { return __uint_as_float(u & 0xffff0000u); }
DI float fast_rcp(float x) { return __builtin_amdgcn_rcpf(x); }
DI float fast_exp2(float x) { return __builtin_amdgcn_exp2f(x); }
DI float sigmoidf_(float x) { return fast_rcp(1.0f + fast_exp2(-x * LOG2E)); }
DI float wave_sum(float v) {
#pragma unroll
    for (int o = 32; o > 0; o >>= 1) v += __shfl_xor(v, o);
    return v;
}
DI float wave_max(float v) {
#pragma unroll
    for (int o = 32; o > 0; o >>= 1) v = fmaxf(v, __shfl_xor(v, o));
    return v;
}

namespace pg8 {
constexpr int BM = 256, BK = 64, HALF = 128, HTB = HALF * BK * 2, NXCD = 8, WGM = 4;
DI int lds_byte(int r, int c) { const int st = (r >> 4) * 2 + (c >> 5), rr = r & 15, cc = c & 31, ob = rr * 64 + cc * 2; return st * 1024 + (ob ^ (((ob >> 9) & 1) << 5)); }
DI void stage_rc(int b, int& R, int& C) { const int st = b / 1024, sb = b % 1024, swz = sb ^ (((sb >> 9) & 1) << 5); R = (st >> 1) * 16 + swz / 64; C = (st & 1) * 32 + (swz % 64) / 2; }
struct Unit { int pm, pn; };
struct Gemm { const bf16_t* A; const bf16_t* Bt; int M, N, K; };
struct StaticOrder {
    int nM, nN, nwg, G, c;
    DI void init(int M, int N, int G_, int c_) { nM = M / BM; nN = N / BM; nwg = nM * nN; G = G_; c = c_; }
    DI bool next(int i, Unit& u) const {
        const long L = (long)i * G + c; if (L >= nwg) return false;
        int wgid = (int)L; { const int q = nwg / NXCD, r = nwg % NXCD, xcd = wgid % NXCD, off = wgid / NXCD; wgid = (xcd < r ? xcd * (q + 1) : r * (q + 1) + (xcd - r) * q) + off; }
        const int nig = WGM * nN, gid = wgid / nig, fm = gid * WGM, gsz = (nM - fm) < WGM ? (nM - fm) : WGM;
        u.pm = fm + ((wgid % nig) % gsz); u.pn = (wgid % nig) / gsz; return true;
    }
};

template <class Epi>
DI void epi_big(const Epi& E, const f32x4 (&acc)[2][2][4][2], const Unit& u, int wr, int wc, int fr, int fq) {
#pragma unroll
    for (int ai = 0; ai < 2; ++ai)
#pragma unroll
        for (int m = 0; m < 4; ++m) {
            const int row = u.pm * BM + ai * HALF + wr * 64 + m * 16 + fr;
            if constexpr (Epi::PAIR) E.apply2(row, u.pn, wc, fq, acc[ai][0][m][0], acc[ai][0][m][1], acc[ai][1][m][0], acc[ai][1][m][1]);
            else {
#pragma unroll
                for (int bj = 0; bj < 2; ++bj) E.apply(row, u.pn * BM + bj * HALF + wc * 32, fq, acc[ai][bj][m][0], acc[ai][bj][m][1]);
            }
        }
}

template <class Epi>
DI void gemm_phase(LAS unsigned char* lds, const Gemm g, const StaticOrder& S, const Epi& E) {
    const int tid = otid(), wid = __builtin_amdgcn_readfirstlane(tid >> 6), lane = tid & 63, wr = wid >> 2, wc = wid & 3, fr = lane & 15, fq = lane >> 4;
    const int K = g.K, nt = K / BK;
    unsigned voffA[2];
#pragma unroll
    for (int i = 0; i < 2; ++i) { int R, C; stage_rc(tid * 16 + i * 8192, R, C); voffA[i] = (unsigned)(R * K + C) * 2u; }
    const size_t kstep = (size_t)(BK * 2);
    const size_t hstep = (size_t)HALF * K * 2;
    const size_t tstep = 2 * hstep;
    const unsigned ldsw = (unsigned)wid * 1024u;
    const int aoff = lds_byte(wr * 64 + fr, fq * 8), boff = lds_byte(wc * 32 + fr, fq * 8);
#define PG8_SA(b, h) (((b) * 2 + (h)) * HTB)
#define PG8_SB(b, h) ((4 + (b) * 2 + (h)) * HTB)
#define PG8_STAGE(bufoff, gbase, voff) do { _Pragma("unroll") for (int _i = 0; _i < 2; ++_i) \
        __builtin_amdgcn_global_load_lds((const unsigned*)((const char*)(gbase) + (voff)[_i]), (LAS unsigned*)(lds + (bufoff) + ldsw + _i * 8192), 16, 0, 0); } while (0)
#define PG8_LDA(dst, b, h) do { _Pragma("unroll") for (int m = 0; m < 4; ++m) _Pragma("unroll") for (int k = 0; k < 2; ++k) dst[m][k] = *(const LAS bf16x8*)(lds + PG8_SA(b, h) + aoff + m * 2048 + k * 1024); } while (0)
#define PG8_LDB(dst, b, h) do { _Pragma("unroll") for (int n = 0; n < 2; ++n) _Pragma("unroll") for (int k = 0; k < 2; ++k) dst[n][k] = *(const LAS bf16x8*)(lds + PG8_SB(b, h) + boff + n * 2048 + k * 1024); } while (0)
#define PG8_MMA(ai, bj, At, Bt) do { __builtin_amdgcn_s_setprio(1); _Pragma("unroll") for (int m = 0; m < 4; ++m) _Pragma("unroll") for (int n = 0; n < 2; ++n) _Pragma("unroll") for (int k = 0; k < 2; ++k) \
        acc[ai][bj][m][n] = __builtin_amdgcn_mfma_f32_16x16x32_bf16(Bt[n][k], At[m][k], acc[ai][bj][m][n], 0, 0, 0); __builtin_amdgcn_s_setprio(0); } while (0)
#define PG8_WAIT_V(n) asm volatile("s_waitcnt vmcnt(" #n ")" ::: "memory")
#define PG8_WAIT_L(n) asm volatile("s_waitcnt lgkmcnt(" #n ")" ::: "memory")
#define PG8_BAR __builtin_amdgcn_s_barrier()
#define PG8_SCHED __builtin_amdgcn_sched_barrier(0)
    Unit cur, nxt; int ui = 0;
    if (!S.next(0, cur)) return;
    f32x4 acc[2][2][4][2];
#pragma unroll
    for (int a = 0; a < 2; ++a)
#pragma unroll
        for (int b = 0; b < 2; ++b)
#pragma unroll
            for (int m = 0; m < 4; ++m)
#pragma unroll
                for (int n = 0; n < 2; ++n) acc[a][b][m][n] = (f32x4){0.f, 0.f, 0.f, 0.f};
    bf16x8 At[4][2], B0[2][2], B1[2][2];
    const char* cA = (const char*)g.A + (size_t)cur.pm * tstep; const char* cB = (const char*)g.Bt + (size_t)cur.pn * tstep;
    PG8_STAGE(PG8_SB(0, 0), cB, voffA); PG8_STAGE(PG8_SB(0, 1), cB + hstep, voffA); PG8_STAGE(PG8_SA(0, 0), cA, voffA); PG8_STAGE(PG8_SA(0, 1), cA + hstep, voffA);
    if (wr == 1) PG8_BAR;
    PG8_WAIT_V(2); PG8_BAR;
    PG8_STAGE(PG8_SB(1, 0), cB + kstep, voffA); PG8_STAGE(PG8_SA(1, 0), cA + kstep, voffA); PG8_STAGE(PG8_SB(1, 1), cB + hstep + kstep, voffA);
    PG8_WAIT_V(6); PG8_BAR;
    for (;;) {
        const bool has_next = S.next(ui + 1, nxt);
        const char* nA = has_next ? (const char*)g.A + (size_t)nxt.pm * tstep : cA; const char* nB = has_next ? (const char*)g.Bt + (size_t)nxt.pn * tstep : cB;
        for (int t = 0; t < nt; t += 2) {
            const bool last = (t == nt - 2);
            const char* a1 = cA + (size_t)(t + 1) * kstep;
            const char* a2 = last ? nA : cA + (size_t)(t + 2) * kstep; const char* b2 = last ? nB : cB + (size_t)(t + 2) * kstep;
            const char* a3 = a2 + kstep; const char* b3 = b2 + kstep;
            PG8_LDB(B0, 0, 0); PG8_LDB(B1, 0, 1); PG8_SCHED; PG8_LDA(At, 0, 0); PG8_STAGE(PG8_SA(1, 1), a1 + hstep, voffA);
            PG8_WAIT_V(8); PG8_WAIT_L(0); PG8_BAR; PG8_MMA(0, 0, At, B0); PG8_MMA(0, 1, At, B1); PG8_BAR; PG8_SCHED;
            PG8_LDA(At, 0, 1); PG8_STAGE(PG8_SB(0, 0), b2, voffA); PG8_STAGE(PG8_SB(0, 1), b2 + hstep, voffA); PG8_STAGE(PG8_SA(0, 0), a2, voffA);
            PG8_WAIT_V(8); PG8_WAIT_L(0); PG8_BAR; PG8_MMA(1, 0, At, B0); PG8_MMA(1, 1, At, B1); PG8_BAR; PG8_SCHED;
            PG8_LDB(B0, 1, 0); PG8_LDB(B1, 1, 1); PG8_SCHED; PG8_LDA(At, 1, 0); PG8_STAGE(PG8_SA(0, 1), a2 + hstep, voffA);
            PG8_WAIT_V(8); PG8_WAIT_L(0); PG8_BAR; PG8_MMA(0, 0, At, B0); PG8_MMA(0, 1, At, B1); PG8_BAR; PG8_SCHED;
            PG8_LDA(At, 1, 1); PG8_STAGE(PG8_SB(1, 0), b3, voffA); PG8_STAGE(PG8_SB(1, 1), b3 + hstep, voffA); PG8_STAGE(PG8_SA(1, 0), a3, voffA);
            PG8_WAIT_V(8); PG8_WAIT_L(0); PG8_BAR; PG8_MMA(1, 0, At, B0); PG8_MMA(1, 1, At, B1); PG8_BAR; PG8_SCHED;
        }
        if (wr == 0) PG8_BAR;
        epi_big(E, acc, cur, wr, wc, fr, fq);
        if (EPI_TWICE) { asm volatile("" ::: "memory"); epi_big(E, acc, cur, wr, wc, fr, fq); }
        if (!has_next) break;
#pragma unroll
        for (int a = 0; a < 2; ++a)
#pragma unroll
            for (int b = 0; b < 2; ++b)
#pragma unroll
                for (int m = 0; m < 4; ++m)
#pragma unroll
                    for (int n = 0; n < 2; ++n) acc[a][b][m][n] = (f32x4){0.f, 0.f, 0.f, 0.f};
        cur = nxt; cA = nA; cB = nB; ++ui;
        if (wr == 1) PG8_BAR;
    }
    PG8_WAIT_V(0);
    PG8_BAR;
#undef PG8_SA
#undef PG8_SB
#undef PG8_STAGE
#undef PG8_LDA
#undef PG8_LDB
#undef PG8_MMA
#undef PG8_WAIT_V
#undef PG8_WAIT_L
#undef PG8_BAR
#undef PG8_SCHED
}
}

template <class Epi>
DI void small_gemm(unsigned char* lds, const bf16_t* A  , const bf16_t* Bt, int N, int K, const Epi& E) {
    const int tid = otid(), wid = tid >> 6, lane = tid & 63, fr = lane & 15, fq = lane >> 4;
    const int G = gridDim.x, nun = (N / 32) * 8, kw = K / 8, nks = kw / 32;
    f32x4* red = (f32x4*)lds;
    for (int u = (G - 1 - obid()); u < nun; u += G) {
        const int q = u >> 3, rb = u & 7;
        const bf16_t* ap = A + (size_t)(rb * 16 + fr) * K + wid * kw + fq * 8;
        const bf16_t* b0 = Bt + (size_t)(q * 32 + fr) * K + wid * kw + fq * 8;
        const bf16_t* b1 = b0 + (size_t)16 * K;
        f32x4 c0 = {0.f, 0.f, 0.f, 0.f}, c1 = {0.f, 0.f, 0.f, 0.f};
        if (nks == 11) {
            bf16x8 af[11], w0[11], w1[11];
#pragma unroll
            for (int j = 0; j < 11; ++j) { af[j] = *(const bf16x8*)(ap + j * 32); w0[j] = *(const bf16x8*)(b0 + j * 32); w1[j] = *(const bf16x8*)(b1 + j * 32); }
            __builtin_amdgcn_sched_barrier(0);
#pragma unroll
            for (int j = 0; j < 11; ++j) {
                c0 = __builtin_amdgcn_mfma_f32_16x16x32_bf16(w0[j], af[j], c0, 0, 0, 0);
                c1 = __builtin_amdgcn_mfma_f32_16x16x32_bf16(w1[j], af[j], c1, 0, 0, 0);
            }
            __builtin_amdgcn_sched_barrier(0);
        } else if (nks == 4) {
            bf16x8 af[4], w0[4], w1[4];
#pragma unroll
            for (int j = 0; j < 4; ++j) { af[j] = *(const bf16x8*)(ap + j * 32); w0[j] = *(const bf16x8*)(b0 + j * 32); w1[j] = *(const bf16x8*)(b1 + j * 32); }
            __builtin_amdgcn_sched_barrier(0);
#pragma unroll
            for (int j = 0; j < 4; ++j) {
                c0 = __builtin_amdgcn_mfma_f32_16x16x32_bf16(w0[j], af[j], c0, 0, 0, 0);
                c1 = __builtin_amdgcn_mfma_f32_16x16x32_bf16(w1[j], af[j], c1, 0, 0, 0);
            }
            __builtin_amdgcn_sched_barrier(0);
        } else {
            for (int ks = 0; ks < nks; ++ks) {
                const bf16x8 af = *(const bf16x8*)(ap + ks * 32), w0 = *(const bf16x8*)(b0 + ks * 32), w1 = *(const bf16x8*)(b1 + ks * 32);
                c0 = __builtin_amdgcn_mfma_f32_16x16x32_bf16(w0, af, c0, 0, 0, 0);
                c1 = __builtin_amdgcn_mfma_f32_16x16x32_bf16(w1, af, c1, 0, 0, 0);
            }
        }
        red[(wid * 2 + 0) * 64 + lane] = c0; red[(wid * 2 + 1) * 64 + lane] = c1;
        __syncthreads();
        if (wid == 0) {
            f32x4 s0 = red[lane], s1 = red[64 + lane];
#pragma unroll
            for (int w = 1; w < 8; ++w) { s0 += red[(w * 2) * 64 + lane]; s1 += red[(w * 2 + 1) * 64 + lane]; }
            E.apply(NP + rb * 16 + fr, q * 32, fq, s0, s1);
        }
        __syncthreads();
    }
}

template <class Epi>
DI void small_gemm3(unsigned char* lds, const bf16_t* A, const bf16_t* Bt, int N, const Epi& E) {
    constexpr int K = 1024, kw = 128;
    const int tid = otid(), wid = tid >> 6, lane = tid & 63, fr = lane & 15, fq = lane >> 4;
    const int G = gridDim.x, nun = (N / 32) * 8;
    f32x4* red = (f32x4*)lds;
    for (int u0 = (G - 1 - obid()); u0 < nun; u0 += 3 * G) {
        bf16x8 af[3][4], w0[3][4], w1[3][4];
#pragma unroll
        for (int t = 0; t < 3; ++t) {
            const int u = u0 + t * G, uu = u < nun ? u : u0;
            const int q = uu >> 3, rb = uu & 7;
            const bf16_t* ap = A + (size_t)(rb * 16 + fr) * K + wid * kw + fq * 8;
            const bf16_t* b0 = Bt + (size_t)(q * 32 + fr) * K + wid * kw + fq * 8;
            const bf16_t* b1 = b0 + (size_t)16 * K;
#pragma unroll
            for (int j = 0; j < 4; ++j) { af[t][j] = *(const bf16x8*)(ap + j * 32); w0[t][j] = *(const bf16x8*)(b0 + j * 32); w1[t][j] = *(const bf16x8*)(b1 + j * 32); }
        }
        __builtin_amdgcn_sched_barrier(0);
#pragma unroll
        for (int t = 0; t < 3; ++t) {
            f32x4 c0 = {0.f, 0.f, 0.f, 0.f}, c1 = {0.f, 0.f, 0.f, 0.f};
#pragma unroll
            for (int j = 0; j < 4; ++j) {
                c0 = __builtin_amdgcn_mfma_f32_16x16x32_bf16(w0[t][j], af[t][j], c0, 0, 0, 0);
                c1 = __builtin_amdgcn_mfma_f32_16x16x32_bf16(w1[t][j], af[t][j], c1, 0, 0, 0);
            }
            red[((t * 8 + wid) * 2 + 0) * 64 + lane] = c0; red[((t * 8 + wid) * 2 + 1) * 64 + lane] = c1;
        }
        __syncthreads();
        if (wid < 3) {
            const int u = u0 + wid * G;
            if (u < nun) {
                f32x4 s0 = red[((wid * 8) * 2) * 64 + lane], s1 = red[((wid * 8) * 2 + 1) * 64 + lane];
#pragma unroll
                for (int w = 1; w < 8; ++w) { s0 += red[((wid * 8 + w) * 2) * 64 + lane]; s1 += red[((wid * 8 + w) * 2 + 1) * 64 + lane]; }
                E.apply(NP + (u & 7) * 16 + fr, (u >> 3) * 32, fq, s0, s1);
            }
        }
        __syncthreads();
    }
}

template <class Epi>
DI void small_gemm_rows(const bf16_t* A, const bf16_t* Bt, int N, int K, const Epi& E, int first_wg) {
    const int tid = otid(), wid = tid >> 6, lane = tid & 63, fr = lane & 15, fq = lane >> 4;
    const int G = gridDim.x, bid = obid(), nun = N / 32, nks = K / 32;
    if (bid < first_wg) return;
    const int stride = G - first_wg;
    const bf16_t* ap = A + (size_t)(wid * 16 + fr) * K + fq * 8;
    for (int u = G - 1 - bid; u < nun; u += stride) {
        const bf16_t* b0 = Bt + (size_t)(u * 32 + fr) * K + fq * 8;
        const bf16_t* b1 = b0 + (size_t)16 * K;
        f32x4 c0 = {0.f, 0.f, 0.f, 0.f}, c1 = {0.f, 0.f, 0.f, 0.f};
        for (int ks0 = 0; ks0 < nks; ks0 += 8) {
            bf16x8 af[8], w0[8], w1[8];
#pragma unroll
            for (int j = 0; j < 8; ++j) { af[j] = *(const bf16x8*)(ap + (ks0 + j) * 32); w0[j] = *(const bf16x8*)(b0 + (ks0 + j) * 32); w1[j] = *(const bf16x8*)(b1 + (ks0 + j) * 32); }
            __builtin_amdgcn_sched_barrier(0);
#pragma unroll
            for (int j = 0; j < 8; ++j) {
                c0 = __builtin_amdgcn_mfma_f32_16x16x32_bf16(w0[j], af[j], c0, 0, 0, 0);
                c1 = __builtin_amdgcn_mfma_f32_16x16x32_bf16(w1[j], af[j], c1, 0, 0, 0);
            }
            __builtin_amdgcn_sched_barrier(0);
        }
        E.apply(NP + wid * 16 + fr, u * 32, fq, c0, c1);
    }
}

struct EpiSwiglu {
    static constexpr bool PAIR = true;
    bf16_t* act;
    DI void apply(int row, int c32, int fq, f32x4 g, f32x4 u) const {
        float r[4];
#pragma unroll
        for (int j = 0; j < 4; ++j) r[j] = g[j] * sigmoidf_(g[j]) * u[j];
        u32x2 w; w.x = pk_bf16(r[0], r[1]); w.y = pk_bf16(r[2], r[3]);
        const int col = (c32 >> 8) * 128 + ((c32 >> 5) & 3) * 32 + 8 * fq + ((c32 >> 7) & 1) * 4;
        *(u32x2*)(act + (size_t)row * FF + col) = w;
    }
    DI void apply2(int row, int pn, int wc, int fq, f32x4 g0, f32x4 u0, f32x4 g1, f32x4 u1) const {
        float r[8];
#pragma unroll
        for (int j = 0; j < 4; ++j) { r[j] = g0[j] * sigmoidf_(g0[j]) * u0[j]; r[4 + j] = g1[j] * sigmoidf_(g1[j]) * u1[j]; }
        u32x4 w; w.x = pk_bf16(r[0], r[1]); w.y = pk_bf16(r[2], r[3]); w.z = pk_bf16(r[4], r[5]); w.w = pk_bf16(r[6], r[7]);
        *(u32x4*)(act + (size_t)row * FF + pn * 128 + wc * 32 + 8 * fq) = w;
    }
};
struct EpiGlu {
    static constexpr bool PAIR = true;
    bf16_t* y;
    DI void apply(int row, int c32, int fq, f32x4 v, f32x4 g) const {
        float r[4];
#pragma unroll
        for (int j = 0; j < 4; ++j) r[j] = v[j] * sigmoidf_(g[j]);
        u32x2 w; w.x = pk_bf16(r[0], r[1]); w.y = pk_bf16(r[2], r[3]);
        const int col = (c32 >> 8) * 128 + ((c32 >> 5) & 3) * 32 + 8 * fq + ((c32 >> 7) & 1) * 4;
        *(u32x2*)(y + (size_t)row * D + col) = w;
    }
    DI void apply2(int row, int pn, int wc, int fq, f32x4 v0, f32x4 g0, f32x4 v1, f32x4 g1) const {
        float r[8];
#pragma unroll
        for (int j = 0; j < 4; ++j) { r[j] = v0[j] * sigmoidf_(g0[j]); r[4 + j] = v1[j] * sigmoidf_(g1[j]); }
        u32x4 w; w.x = pk_bf16(r[0], r[1]); w.y = pk_bf16(r[2], r[3]); w.z = pk_bf16(r[4], r[5]); w.w = pk_bf16(r[6], r[7]);
        *(u32x4*)(y + (size_t)row * D + pn * 128 + wc * 32 + 8 * fq) = w;
    }
};
struct EpiF32 {
    static constexpr bool PAIR = false;
    float* y;
    DI void apply(int row, int c32, int fq, f32x4 v0, f32x4 v1) const {
        float* p = y + (size_t)row * D + c32 + 4 * fq;
        *(f32x4*)p = v0; *(f32x4*)(p + 16) = v1;
    }
};
struct EpiBf16 {
    static constexpr bool PAIR = false;
    bf16_t* o;
    DI void apply(int row, int c32, int fq, f32x4 v0, f32x4 v1) const {
        u32x4 w; w.x = pk_bf16(v0[0], v0[1]); w.y = pk_bf16(v0[2], v0[3]); w.z = pk_bf16(v1[0], v1[1]); w.w = pk_bf16(v1[2], v1[3]);
        *(u32x4*)(o + (size_t)row * D + c32 + 8 * fq) = w;
    }
};
struct EpiKV {
    static constexpr bool PAIR = false;
    bf16_t* kb; bf16_t* vt; float* out;
    DI void one(int row, int c, f32x4 v) const {
        if (row >= NP) {
            const int r = row - NP;
            if (c < D) *(f32x4*)(out + O_KS + (size_t)r * D + c) = v;
            else *(f32x4*)(out + O_VS + (size_t)r * D + (c - D)) = v;
            return;
        }
        const int n = row >> 11, pos = row & 2047;
        if (c < D) {
            u32x2 a; a.x = pk_bf16(v[0], v[1]); a.y = pk_bf16(v[2], v[3]);
            *(u32x2*)(kb + (size_t)row * D + c) = a;
            if (pos >= 1536) *(f32x4*)(out + O_KP + ((size_t)n * 512 + (pos - 1536)) * D + c) = v;
        } else {
            const int cv = c - D;
            const unsigned p01 = pk_bf16(v[0], v[1]), p23 = pk_bf16(v[2], v[3]);
            const int pp = (pos & ~15) | (((pos >> 2) & 1) << 3) | (((pos >> 3) & 1) << 2) | (pos & 3);
            bf16_t* vp = vt + ((size_t)n * D + cv) * SEQ + pp;
            vp[0] = (bf16_t)(p01 & 0xffffu); vp[SEQ] = (bf16_t)(p01 >> 16); vp[2 * SEQ] = (bf16_t)(p23 & 0xffffu); vp[3 * SEQ] = (bf16_t)(p23 >> 16);
            if (pos >= 1536) *(f32x4*)(out + O_VP + ((size_t)n * 512 + (pos - 1536)) * D + cv) = v;
        }
    }
    DI void apply(int row, int c32, int fq, f32x4 v0, f32x4 v1) const { one(row, c32 + 4 * fq, v0); one(row, c32 + 16 + 4 * fq, v1); }
};

DI void convert_tile(unsigned char* lds, const float* src, bf16_t* dst, int K, int N, int halfN, int tile) {
    float* T = (float*)lds;
    const int tid = otid();
    const int ntk = K / 64, tn = tile / ntk, tk = tile % ntk, n0 = tn * 256, k0 = tk * 64;
    {
        const int n4 = (tid & 63) * 4, kk = tid >> 6;
        const int np = n0 + n4;
        const int col = halfN == -1 ? ((np & ~31) + 8 * ((np >> 2) & 3) + 4 * ((np >> 4) & 1) + (np & 3)) : (halfN == 2816 || halfN == 1024) ? (((np >> 4) & 1) * halfN + (np >> 8) * 128 + ((np >> 5) & 3) * 32 + ((np >> 2) & 3) * 8 + ((np >> 7) & 1) * 4 + (np & 3))
                      : halfN ? (((np >> 4) & 1) * halfN + (np >> 5) * 16 + (np & 15)) : np;
        f32x4 v[8];
#pragma unroll
        for (int h = 0; h < 8; ++h) v[h] = __builtin_nontemporal_load((const f32x4*)(src + (size_t)(k0 + kk + 8 * h) * N + col));
        __builtin_amdgcn_sched_barrier(0);
#pragma unroll
        for (int h = 0; h < 8; ++h) { float* t = T + (kk + 8 * h) * 257 + n4; t[0] = v[h][0]; t[1] = v[h][1]; t[2] = v[h][2]; t[3] = v[h][3]; }
    }
    __syncthreads();
    {
        const int k8 = (tid & 7) * 8, nr = tid >> 3;
#pragma unroll
        for (int q = 0; q < 4; ++q) {
            const int n = nr + 64 * q;
            float f[8];
#pragma unroll
            for (int j = 0; j < 8; ++j) f[j] = T[(k8 + j) * 257 + n];
            u32x4 w; w.x = pk_bf16(f[0], f[1]); w.y = pk_bf16(f[2], f[3]); w.z = pk_bf16(f[4], f[5]); w.w = pk_bf16(f[6], f[7]);
            __builtin_nontemporal_store(w, (u32x4*)(dst + (size_t)(n0 + n) * K + k0 + k8));
        }
    }
    __syncthreads();
}

struct ConvJob { const float* src; bf16_t* dst; int K, N, halfN; };
DI ConvJob conv_job(const Params& P, int j) {
    ConvJob c;
    if (j < 16) {
        const int L = j >> 2, kind = j & 3;
        if ((kind & 1) == 0) { c.src = P.in[kind == 0 ? 7 : 9] + (size_t)L * 1024 * 5632; c.dst = (bf16_t*)(P.ws + L * SZ_LAYER + (kind == 0 ? 0 : SZ_WIN + SZ_WOUT)); c.K = 1024; c.N = 5632; c.halfN = 2816; }
        else { c.src = P.in[kind == 1 ? 8 : 10] + (size_t)L * 2816 * 1024; c.dst = (bf16_t*)(P.ws + L * SZ_LAYER + (kind == 1 ? SZ_WIN : 2 * SZ_WIN + SZ_WOUT)); c.K = 2816; c.N = 1024; c.halfN = -1; }
    } else if (j < 18) { const int l = j - 16; c.src = P.in[19] + (size_t)l * 1024 * 2048; c.dst = (bf16_t*)(P.ws + OFF_WGLU) + (size_t)l * 2048 * 1024; c.K = 1024; c.N = 2048; c.halfN = 1024; }
    else if (j == 18) { c.src = P.in[21]; c.dst = (bf16_t*)(P.ws + OFF_WKV); c.K = 1024; c.N = 2048; c.halfN = 0; }
    else if (j < 21) { const int b = j - 19; c.src = P.in[22] + (size_t)b * 1024 * 1024; c.dst = (bf16_t*)(P.ws + OFF_WQ) + (size_t)b * 1024 * 1024; c.K = 1024; c.N = 1024; c.halfN = -1; }
    else { const int b = j - 21; c.src = P.in[23] + (size_t)b * 1024 * 1024; c.dst = (bf16_t*)(P.ws + OFF_WO) + (size_t)b * 1024 * 1024; c.K = 1024; c.N = 1024; c.halfN = -1; }
    return c;
}
DI int conv_group(int j) { return (j >= 8 && j <= 15) ? 1 : 0; }
DI void convert_deferred(const Params& P, unsigned char* lds, int slot, int first_wg) {
    const int bid = obid(), G = gridDim.x;
    if (bid < first_wg) return;
    const int lo = slot < 4 ? slot * 264 : 1056 + (slot - 4) * 528, hi = slot < 4 ? lo + 264 : lo + 528, stride = G - first_wg;
    int base = 0;
    for (int j = 8; j < 16; ++j) {
        const ConvJob c = conv_job(P, j);
        const int nt = (c.N / 256) * (c.K / 64);
        const int a = base > lo ? base : lo, b = (base + nt) < hi ? (base + nt) : hi;
        if (a < b) {
            int g = a + ((bid - first_wg) - (a - lo) % stride + stride) % stride;
            for (; g < b; g += stride) convert_tile(lds, c.src, c.dst, c.K, c.N, c.halfN, g - base);
        }
        base += nt;
    }
}
DI void convert_phase(const Params& P, unsigned char* lds) {
    const int G = gridDim.x;
    int base = 0;
    for (int j = 0; j < 23; ++j) {
        if (conv_group(j) != 0) continue;
        const ConvJob c = conv_job(P, j);
        const int nt = (c.N / 256) * (c.K / 64);
        int first = (obid() - base % G + G) % G;
        for (int t = first; t < nt; t += G) convert_tile(lds, c.src, c.dst, c.K, c.N, c.halfN, t);
        base += nt;
    }
}
DI void convert_tile64(unsigned char* wl  , const ConvJob& c, int tile) {
    float* T = (float*)wl;
    const int lane = otid() & 63;
    const int ntk = c.K / 64, tn = tile / ntk, tk = tile % ntk, n0 = tn * 64, k0 = tk * 64;
    {
        const int n4 = (lane & 15) * 4, kq = lane >> 4;
        const int np = n0 + n4;
        const int col = c.halfN == -1 ? ((np & ~31) + 8 * ((np >> 2) & 3) + 4 * ((np >> 4) & 1) + (np & 3)) : (c.halfN == 2816 || c.halfN == 1024) ? (((np >> 4) & 1) * c.halfN + (np >> 8) * 128 + ((np >> 5) & 3) * 32 + ((np >> 2) & 3) * 8 + ((np >> 7) & 1) * 4 + (np & 3))
                      : c.halfN ? (((np >> 4) & 1) * c.halfN + (np >> 5) * 16 + (np & 15)) : np;
        f32x4 v[16];
#pragma unroll
        for (int h = 0; h < 16; ++h) v[h] = *(const f32x4*)(c.src + (size_t)(k0 + 4 * h + kq) * c.N + col);
        __builtin_amdgcn_sched_barrier(0);
#pragma unroll
        for (int h = 0; h < 16; ++h) { float* t = T + (4 * h + kq) * 65 + n4; t[0] = v[h][0]; t[1] = v[h][1]; t[2] = v[h][2]; t[3] = v[h][3]; }
    }
    {
        const int k8 = (lane & 7) * 8, nr = lane >> 3;
#pragma unroll
        for (int q = 0; q < 8; ++q) {
            const int n = nr + 8 * q;
            float f[8];
#pragma unroll
            for (int j = 0; j < 8; ++j) f[j] = T[(k8 + j) * 65 + n];
            u32x4 w; w.x = pk_bf16(f[0], f[1]); w.y = pk_bf16(f[2], f[3]); w.z = pk_bf16(f[4], f[5]); w.w = pk_bf16(f[6], f[7]);
            *(u32x4*)(c.dst + (size_t)(n0 + n) * c.K + k0 + k8) = w;
        }
    }
}
DI void convert_waves(const Params& P, unsigned char* wl, int group, int slot, int nslots) {
    int base = 0;
    for (int j = 0; j < 23; ++j) {
        if (conv_group(j) != group) continue;
        const ConvJob c = conv_job(P, j);
        const int nt = (c.N / 64) * (c.K / 64);
        int first = (slot - base % nslots + nslots) % nslots;
        for (int t = first; t < nt; t += nslots) convert_tile64(wl, c, t);
        base += nt;
    }
}

DI void rowpass(const Params& P, const bf16_t* Y, const float* gpost, float coef, const float* gnext, const float* gkv, bool first) {
    const int tid = otid(), wid = tid >> 6, lane = tid & 63;
    bf16_t* XB = (bf16_t*)(P.ws + OFF_Y) + (size_t)MALL * D;
    bf16_t* XN = (bf16_t*)(P.ws + OFF_XN);
    bf16_t* XKV = (bf16_t*)(P.ws + OFF_QB);
    const bool last = !first && gnext == nullptr;
    f32x4 gp[4], gn[4], gk[4];
#pragma unroll
    for (int i = 0; i < 4; ++i) {
        gp[i] = Y ? *(const f32x4*)(gpost + lane * 4 + 256 * i) : (f32x4){0.f, 0.f, 0.f, 0.f};
        gn[i] = gnext ? *(const f32x4*)(gnext + lane * 4 + 256 * i) : (f32x4){0.f, 0.f, 0.f, 0.f};
        gk[i] = gkv ? *(const f32x4*)(gkv + lane * 4 + 256 * i) : (f32x4){0.f, 0.f, 0.f, 0.f};
    }
    const int half = MALL / 2;
    for (int r0 = obid() * 8 + wid; r0 < half; r0 += gridDim.x * 8) {
        f32x4 x[2][4]; u32x2 y[2][4];
#pragma unroll
        for (int q = 0; q < 2; ++q) {
            const int row = r0 + q * half;
            if (first) {
                const float* src = row < NP ? P.in[0] + (size_t)row * D : P.in[1] + (size_t)(row - NP) * D;
#pragma unroll
                for (int i = 0; i < 4; ++i) x[q][i] = *(const f32x4*)(src + lane * 4 + 256 * i);
            } else {
#pragma unroll
                for (int i = 0; i < 4; ++i) { const u32x2 w = *(const u32x2*)(XB + (size_t)row * D + lane * 4 + 256 * i); x[q][i] = (f32x4){bf_lo(w.x), bf_hi(w.x), bf_lo(w.y), bf_hi(w.y)}; }
            }
            if (Y) {
#pragma unroll
                for (int i = 0; i < 4; ++i) y[q][i] = *(const u32x2*)(Y + (size_t)row * D + lane * 4 + 256 * i);
            }
        }
#pragma unroll
        for (int q = 0; q < 2; ++q) {
            const int row = r0 + q * half;
            if (Y) {
                f32x4 yf[4]; float ss = 0.f;
#pragma unroll
                for (int i = 0; i < 4; ++i) { yf[i] = (f32x4){bf_lo(y[q][i].x), bf_hi(y[q][i].x), bf_lo(y[q][i].y), bf_hi(y[q][i].y)}; ss += yf[i][0] * yf[i][0] + yf[i][1] * yf[i][1] + yf[i][2] * yf[i][2] + yf[i][3] * yf[i][3]; }
                ss = wave_sum(ss);
                const float r = coef * __builtin_amdgcn_rsqf(ss * (1.0f / D) + EPS);
#pragma unroll
                for (int i = 0; i < 4; ++i) x[q][i] += yf[i] * gp[i] * r;
            }
            if (last) {
#pragma unroll
                for (int i = 0; i < 4; ++i) *(f32x4*)(P.out + (size_t)row * D + lane * 4 + 256 * i) = x[q][i];
            } else {
#pragma unroll
                for (int i = 0; i < 4; ++i) { u32x2 w; w.x = pk_bf16(x[q][i][0], x[q][i][1]); w.y = pk_bf16(x[q][i][2], x[q][i][3]); *(u32x2*)(XB + (size_t)row * D + lane * 4 + 256 * i) = w; }
            }
            if (gnext) {
                float ss = 0.f;
#pragma unroll
                for (int i = 0; i < 4; ++i) ss += x[q][i][0] * x[q][i][0] + x[q][i][1] * x[q][i][1] + x[q][i][2] * x[q][i][2] + x[q][i][3] * x[q][i][3];
                ss = wave_sum(ss);
                const float r = __builtin_amdgcn_rsqf(ss * (1.0f / D) + EPS);
#pragma unroll
                for (int i = 0; i < 4; ++i) {
                    const f32x4 v = x[q][i] * gn[i] * r;
                    u32x2 w; w.x = pk_bf16(v[0], v[1]); w.y = pk_bf16(v[2], v[3]);
                    *(u32x2*)(XN + (size_t)row * D + lane * 4 + 256 * i) = w;
                }
                if (gkv) {
#pragma unroll
                    for (int i = 0; i < 4; ++i) {
                        const f32x4 v = x[q][i] * gk[i] * r;
                        u32x2 w; w.x = pk_bf16(v[0], v[1]); w.y = pk_bf16(v[2], v[3]);
                        *(u32x2*)(XKV + (size_t)row * D + lane * 4 + 256 * i) = w;
                    }
                }
            }
        }
    }
}

DI double d_exp_small(double x) {
    const double y = x * 0.0625; double s = 1.0;
#pragma unroll
    for (int k = 14; k >= 1; --k) s = 1.0 + s * y * (1.0 / (double)k);
    s *= s; s *= s; s *= s; s *= s; return s;
}
DI void d_sincos(double a, double& sn, double& cs) {
    const double TWO_PI = 6.283185307179586476925286766559, INV_TWO_PI = 0.15915494309189533576888376337251;
    const double k = __builtin_rint(a * INV_TWO_PI); const double r = a - k * TWO_PI;
    const double r2 = r * r; double s = 1.0, c = 1.0;
#pragma unroll
    for (int i = 14; i >= 1; --i) { s = 1.0 - s * r2 * (1.0 / (double)((2 * i) * (2 * i + 1))); c = 1.0 - c * r2 * (1.0 / (double)((2 * i - 1) * (2 * i))); }
    sn = s * r; cs = c;
}
DI float gelu_tanh(float x) {
    const float z = 0.7978845608028654f * (x + 0.044715f * x * x * x);
    return x * fast_rcp(1.0f + fast_exp2(-2.0f * LOG2E * z));
}
DI void s5_consts(const Params& P, int l, int g, int p, float& ar, float& ai, float& cr, float& ci) {
    const int gp = (l * 64 + g) * 64 + p;
    const double lr = (double)P.in[11][gp], li = (double)P.in[12][gp];
    const double st = d_exp_small((double)P.in[13][l * 64 + g]);
    const double er = d_exp_small(lr * st); double sn, cs; d_sincos(li * st, sn, cs);
    const double dar = er * cs, dai = er * sn;
    const double den = 1.0 / (lr * lr + li * li);
    ar = (float)dar; ai = (float)dai;
    cr = (float)(((dar - 1.0) * lr + dai * li) * den); ci = (float)((dai * lr - (dar - 1.0) * li) * den);
}

DI void s5_item2(const Params& P, unsigned char* wl  , int l, int pair, bool prompt, int g) {
    const int lane = otid() & 63, n = lane & 31, hh = lane >> 5, fr = lane & 15, fq = lane >> 4;
    const int L = prompt ? SEQ : 16;
    const bf16_t* XN = (const bf16_t*)(P.ws + OFF_XN);
    bf16_t* YO = (bf16_t*)(P.ws + OFF_QB);
    float ar0, ai0, ar1, ai1;
    bf16x8 bfr[4];
    {
        float cr0, ci0, cr1, ci1;
        s5_consts(P, l, g, n, ar0, ai0, cr0, ci0);
        s5_consts(P, l, g, 32 + n, ar1, ai1, cr1, ci1);
#pragma unroll
        for (int pb = 0; pb < 2; ++pb) {
            const int gp = (l * 64 + g) * 64 + pb * 32 + n;
            const float crf = pb ? cr1 : cr0, cif = pb ? ci1 : ci0;
            const float* br = P.in[14] + (size_t)gp * 16 + 8 * hh; const float* bi = P.in[15] + (size_t)gp * 16 + 8 * hh;
            const f32x4 r0 = *(const f32x4*)br, r1 = *(const f32x4*)(br + 4), i0 = *(const f32x4*)bi, i1 = *(const f32x4*)(bi + 4);
            u32x4 wr, wi;
            wr.x = pk_bf16(crf * r0[0] - cif * i0[0], crf * r0[1] - cif * i0[1]); wr.y = pk_bf16(crf * r0[2] - cif * i0[2], crf * r0[3] - cif * i0[3]);
            wr.z = pk_bf16(crf * r1[0] - cif * i1[0], crf * r1[1] - cif * i1[1]); wr.w = pk_bf16(crf * r1[2] - cif * i1[2], crf * r1[3] - cif * i1[3]);
            wi.x = pk_bf16(crf * i0[0] + cif * r0[0], crf * i0[1] + cif * r0[1]); wi.y = pk_bf16(crf * i0[2] + cif * r0[2], crf * i0[3] + cif * r0[3]);
            wi.z = pk_bf16(crf * i1[0] + cif * r1[0], crf * i1[1] + cif * r1[1]); wi.w = pk_bf16(crf * i1[2] + cif * r1[2], crf * i1[3] + cif * r1[3]);
            bfr[pb] = __builtin_bit_cast(bf16x8, wr); bfr[2 + pb] = __builtin_bit_cast(bf16x8, wi);
        }
    }
    bf16x8 cf[4];
    {
        const float* cr = P.in[16] + ((size_t)(l * 64 + g) * 16 + fr) * 64; const float* ci = P.in[17] + ((size_t)(l * 64 + g) * 16 + fr) * 64;
#pragma unroll
        for (int ks = 0; ks < 4; ++ks) {
            const int n0 = 8 * ks + 2 * fq;
            const f32x2 ra = *(const f32x2*)(cr + n0), rb = *(const f32x2*)(cr + 32 + n0), ia = *(const f32x2*)(ci + n0), ib = *(const f32x2*)(ci + 32 + n0);
            u32x4 w; w.x = pk_bf16(ra.x, -ia.x); w.y = pk_bf16(rb.x, -ib.x); w.z = pk_bf16(ra.y, -ia.y); w.w = pk_bf16(rb.y, -ib.y);
            cf[ks] = __builtin_bit_cast(bf16x8, w);
        }
    }
    const f32x4 d4 = *(const f32x4*)(P.in[18] + (size_t)l * D + g * 16 + 4 * fq);
    float hr0 = 0.f, hi0 = 0.f, hr1 = 0.f, hi1 = 0.f;
    const int seqh = pair * 2 + hh;
    if (!prompt) { const size_t si = ((size_t)(l * 8 + seqh) * 64 + g) * 64 + n; hr0 = P.in[2][si]; hi0 = P.in[3][si]; hr1 = P.in[2][si + 32]; hi1 = P.in[3][si + 32]; }
    const int sm = (n >> 2) & 1, im = (n & 3) + 4 * (n >> 3);
    const size_t rbA = prompt ? (size_t)(pair * 2 + sm) * SEQ : (size_t)NP + (size_t)(pair * 2 + sm) * 16;
    const bf16_t* ua = XN + (rbA + im) * D + g * 16 + 8 * hh;
    const size_t rb0 = prompt ? (size_t)(pair * 2) * SEQ : (size_t)NP + (size_t)(pair * 2) * 16;
    const size_t rb1 = prompt ? rb0 + SEQ : rb0 + 16;
    const bf16_t* ue0 = XN + (rb0 + fr) * D + g * 16 + 4 * fq; const bf16_t* ue1 = XN + (rb1 + fr) * D + g * 16 + 4 * fq;
    bf16_t* yo0 = YO + (rb0 + fr) * D + g * 16 + 4 * fq; bf16_t* yo1 = YO + (rb1 + fr) * D + g * 16 + 4 * fq;
    const int nblk = L / 16;
    bf16x8 an = *(const bf16x8*)ua; u32x2 e0n = *(const u32x2*)ue0, e1n = *(const u32x2*)ue1;
    for (int blk = 0; blk < nblk; ++blk) {
        const bf16x8 af = an; const u32x2 e0 = e0n, e1 = e1n;
        if (blk + 1 < nblk) { const size_t o = (size_t)(blk + 1) * 16 * D; an = *(const bf16x8*)(ua + o); e0n = *(const u32x2*)(ue0 + o); e1n = *(const u32x2*)(ue1 + o); }
        f32x16 z;
#pragma unroll
        for (int i = 0; i < 16; ++i) z[i] = 0.f;
        f32x16 bre0 = __builtin_amdgcn_mfma_f32_32x32x16_bf16(af, bfr[0], z, 0, 0, 0);
        f32x16 bre1 = __builtin_amdgcn_mfma_f32_32x32x16_bf16(af, bfr[1], z, 0, 0, 0);
        f32x16 bim0 = __builtin_amdgcn_mfma_f32_32x32x16_bf16(af, bfr[2], z, 0, 0, 0);
        f32x16 bim1 = __builtin_amdgcn_mfma_f32_32x32x16_bf16(af, bfr[3], z, 0, 0, 0);
#pragma unroll
        for (int i = 0; i < 16; ++i) {
            const float nr0 = ar0 * hr0 - ai0 * hi0 + bre0[i], ni0 = ar0 * hi0 + ai0 * hr0 + bim0[i];
            const float nr1 = ar1 * hr1 - ai1 * hi1 + bre1[i], ni1 = ar1 * hi1 + ai1 * hr1 + bim1[i];
            hr0 = nr0; hi0 = ni0; hr1 = nr1; hi1 = ni1;
            u32x2 w; w.x = pk_bf16(hr0, hi0); w.y = pk_bf16(hr1, hi1);
            *(u32x2*)(wl + (hh * 16 + i) * 272 + n * 8) = w;
        }
        f32x4 y0 = {0.f, 0.f, 0.f, 0.f}, y1 = {0.f, 0.f, 0.f, 0.f};
#pragma unroll
        for (int ks = 0; ks < 4; ++ks) {
            const bf16x8 h0 = *(const bf16x8*)(wl + fr * 272 + (32 * ks + 8 * fq) * 2);
            const bf16x8 h1 = *(const bf16x8*)(wl + (16 + fr) * 272 + (32 * ks + 8 * fq) * 2);
            y0 = __builtin_amdgcn_mfma_f32_16x16x32_bf16(cf[ks], h0, y0, 0, 0, 0);
            y1 = __builtin_amdgcn_mfma_f32_16x16x32_bf16(cf[ks], h1, y1, 0, 0, 0);
        }
        {
            const float u0[4] = {bf_lo(e0.x), bf_hi(e0.x), bf_lo(e0.y), bf_hi(e0.y)}, u1[4] = {bf_lo(e1.x), bf_hi(e1.x), bf_lo(e1.y), bf_hi(e1.y)};
            float a[4], b[4];
#pragma unroll
            for (int j = 0; j < 4; ++j) { a[j] = gelu_tanh(y0[j] + d4[j] * u0[j]); b[j] = gelu_tanh(y1[j] + d4[j] * u1[j]); }
            u32x2 w0, w1; w0.x = pk_bf16(a[0], a[1]); w0.y = pk_bf16(a[2], a[3]); w1.x = pk_bf16(b[0], b[1]); w1.y = pk_bf16(b[2], b[3]);
            const size_t o = (size_t)blk * 16 * D;
            *(u32x2*)(yo0 + o) = w0; *(u32x2*)(yo1 + o) = w1;
        }
    }
    {
        const size_t si = ((size_t)(l * 8 + seqh) * 64 + g) * 64 + n;
        float* ore = P.out + (prompt ? O_SRP : O_SRS); float* oim = P.out + (prompt ? O_SIP : O_SIS);
        ore[si] = hr0; oim[si] = hi0; ore[si + 32] = hr1; oim[si + 32] = hi1;
    }
}

DI void s5_phase(const Params& P, unsigned char* lds, int l) {
    const int tid = otid(), wid = __builtin_amdgcn_readfirstlane(tid >> 6), lane = tid & 63;
    const int n = lane & 31, hh = lane >> 5, fr = lane & 15, fq = lane >> 4;
    const bf16_t* XN = (const bf16_t*)(P.ws + OFF_XN);
    bf16_t* YO = (bf16_t*)(P.ws + OFF_QB);
    const bool prompt = wid < 4, active = true;
    const int role = wid & 3;
    const bool roleA = role < 2;
    unsigned char* hbuf = lds + (prompt ? 0 : 17408);
    for (int it = obid(); it < 256; it += gridDim.x) {
        const int pair = it >> 6, g = it & 63;
        const int nblk = prompt ? SEQ / 16 : 1;
        const size_t rb0 = prompt ? (size_t)(pair * 2) * SEQ : (size_t)NP + (size_t)(pair * 2) * 16;
        const size_t rb1 = prompt ? rb0 + SEQ : rb0 + 16;
        float ar = 0.f, ai = 0.f, hr = 0.f, hi = 0.f;
        bf16x8 frag[4]; bf16x8 an; const bf16_t* ua = XN;
        const int seqh = pair * 2 + hh, pst = 32 * (role & 1) + n;
        f32x4 d4 = {0.f, 0.f, 0.f, 0.f}; u32x2 e0n; const bf16_t* ue0 = XN; bf16_t* yo0 = YO; const int bs = role & 1;
#pragma unroll
        for (int k = 0; k < 4; ++k) frag[k] = (bf16x8){0, 0, 0, 0, 0, 0, 0, 0};
        an = (bf16x8){0, 0, 0, 0, 0, 0, 0, 0}; e0n = (u32x2){0u, 0u};
        bf16x8 an1 = an, an2 = an, an3 = an; u32x2 e1q = e0n, e2q = e0n, e3q = e0n;
        if (active && roleA) {
            float crf, cif;
            s5_consts(P, l, g, pst, ar, ai, crf, cif);
            const int gp = (l * 64 + g) * 64 + pst;
            const float* br = P.in[14] + (size_t)gp * 16 + 8 * hh; const float* bi = P.in[15] + (size_t)gp * 16 + 8 * hh;
            const f32x4 r0 = *(const f32x4*)br, r1 = *(const f32x4*)(br + 4), i0 = *(const f32x4*)bi, i1 = *(const f32x4*)(bi + 4);
            u32x4 wr, wi;
            wr.x = pk_bf16(crf * r0[0] - cif * i0[0], crf * r0[1] - cif * i0[1]); wr.y = pk_bf16(crf * r0[2] - cif * i0[2], crf * r0[3] - cif * i0[3]);
            wr.z = pk_bf16(crf * r1[0] - cif * i1[0], crf * r1[1] - cif * i1[1]); wr.w = pk_bf16(crf * r1[2] - cif * i1[2], crf * r1[3] - cif * i1[3]);
            wi.x = pk_bf16(crf * i0[0] + cif * r0[0], crf * i0[1] + cif * r0[1]); wi.y = pk_bf16(crf * i0[2] + cif * r0[2], crf * i0[3] + cif * r0[3]);
            wi.z = pk_bf16(crf * i1[0] + cif * r1[0], crf * i1[1] + cif * r1[1]); wi.w = pk_bf16(crf * i1[2] + cif * r1[2], crf * i1[3] + cif * r1[3]);
            frag[0] = __builtin_bit_cast(bf16x8, wr); frag[1] = __builtin_bit_cast(bf16x8, wi);
            if (!prompt) { const size_t si = ((size_t)(l * 8 + seqh) * 64 + g) * 64 + pst; hr = P.in[2][si]; hi = P.in[3][si]; }
            const int sm = (n >> 2) & 1, im = (n & 3) + 4 * (n >> 3);
            ua = XN + ((sm ? rb1 : rb0) + im) * D + g * 16 + 8 * hh;
            an = *(const bf16x8*)ua;
            if (nblk > 1) an1 = *(const bf16x8*)(ua + (size_t)1 * 16 * D);
            if (nblk > 2) an2 = *(const bf16x8*)(ua + (size_t)2 * 16 * D);
            if (nblk > 3) an3 = *(const bf16x8*)(ua + (size_t)3 * 16 * D);
        }
        if (active && !roleA) {
            const float* cr = P.in[16] + ((size_t)(l * 64 + g) * 16 + fr) * 64; const float* ci = P.in[17] + ((size_t)(l * 64 + g) * 16 + fr) * 64;
#pragma unroll
            for (int ks = 0; ks < 4; ++ks) {
                const int n0 = 8 * ks + 2 * fq;
                const f32x2 ra = *(const f32x2*)(cr + n0), rb = *(const f32x2*)(cr + 32 + n0), ia = *(const f32x2*)(ci + n0), ib = *(const f32x2*)(ci + 32 + n0);
                u32x4 w; w.x = pk_bf16(ra.x, -ia.x); w.y = pk_bf16(rb.x, -ib.x); w.z = pk_bf16(ra.y, -ia.y); w.w = pk_bf16(rb.y, -ib.y);
                frag[ks] = __builtin_bit_cast(bf16x8, w);
            }
            d4 = *(const f32x4*)(P.in[18] + (size_t)l * D + g * 16 + 4 * fq);
            ue0 = XN + ((bs ? rb1 : rb0) + fr) * D + g * 16 + 4 * fq;
            yo0 = YO + ((bs ? rb1 : rb0) + fr) * D + g * 16 + 4 * fq;
            e0n = *(const u32x2*)ue0;
            if (nblk > 1) e1q = *(const u32x2*)(ue0 + (size_t)1 * 16 * D);
            if (nblk > 2) e2q = *(const u32x2*)(ue0 + (size_t)2 * 16 * D);
            if (nblk > 3) e3q = *(const u32x2*)(ue0 + (size_t)3 * 16 * D);
        }
        const int nsteps = SEQ / 16 + 4;
#define S5_BARRIER() do { asm volatile("s_waitcnt lgkmcnt(0)" ::: "memory"); __builtin_amdgcn_s_barrier(); asm volatile("" ::: "memory"); } while (0)
#define S5_A(step, ANQ) do { \
            const bf16x8 af = ANQ; \
            { const int nb_ = (step) + 4 < nblk ? (step) + 4 : nblk - 1; ANQ = *(const bf16x8*)(ua + (size_t)nb_ * 16 * D); } \
            if ((step) < nblk) { \
                f32x16 z; \
                _Pragma("unroll") for (int i = 0; i < 16; ++i) z[i] = 0.f; \
                const f32x16 bre = __builtin_amdgcn_mfma_f32_32x32x16_bf16(af, frag[0], z, 0, 0, 0); \
                const f32x16 bim = __builtin_amdgcn_mfma_f32_32x32x16_bf16(af, frag[1], z, 0, 0, 0); \
                unsigned char* wl = hbuf + ((step) & 1) * 8704 + (role & 1) * 4; \
                _Pragma("unroll") for (int i = 0; i < 16; ++i) { \
                    float t1 = __builtin_fmaf(-ai, hi, bre[i]), t2 = __builtin_fmaf(ai, hr, bim[i]); \
                    asm volatile("" : "+v"(t1), "+v"(t2));     \
                    float nr = __builtin_fmaf(ar, hr, t1), ni = __builtin_fmaf(ar, hi, t2); \
                    asm volatile("" : "+v"(nr), "+v"(ni)); \
                    hr = nr; hi = ni; \
                    *(unsigned*)(wl + (hh * 16 + i) * 272 + n * 8) = pk_bf16(hr, hi); \
                } \
            } \
            S5_BARRIER(); \
        } while (0)
#define S5_B(step, EQ) do { \
            const int blk = (step) - 1; \
            const u32x2 e0 = EQ; \
            { const int nb_ = blk + 4 < nblk ? (blk + 4 > 0 ? blk + 4 : 0) : nblk - 1; EQ = *(const u32x2*)(ue0 + (size_t)nb_ * 16 * D); } \
            if ((step) >= 1 && (step) <= nblk) { \
                const unsigned char* wl = hbuf + (blk & 1) * 8704 + bs * 16 * 272; \
                f32x4 y0 = {0.f, 0.f, 0.f, 0.f}, y1 = {0.f, 0.f, 0.f, 0.f}; \
                { \
                    const bf16x8 h0 = *(const bf16x8*)(wl + fr * 272 + (8 * fq) * 2), h1 = *(const bf16x8*)(wl + fr * 272 + (32 + 8 * fq) * 2); \
                    const bf16x8 h2 = *(const bf16x8*)(wl + fr * 272 + (64 + 8 * fq) * 2), h3 = *(const bf16x8*)(wl + fr * 272 + (96 + 8 * fq) * 2); \
                    y0 = __builtin_amdgcn_mfma_f32_16x16x32_bf16(frag[0], h0, y0, 0, 0, 0); \
                    y1 = __builtin_amdgcn_mfma_f32_16x16x32_bf16(frag[1], h1, y1, 0, 0, 0); \
                    y0 = __builtin_amdgcn_mfma_f32_16x16x32_bf16(frag[2], h2, y0, 0, 0, 0); \
                    y1 = __builtin_amdgcn_mfma_f32_16x16x32_bf16(frag[3], h3, y1, 0, 0, 0); \
                } \
                const float u0[4] = {bf_lo(e0.x), bf_hi(e0.x), bf_lo(e0.y), bf_hi(e0.y)}; \
                float a[4]; \
                _Pragma("unroll") for (int j = 0; j < 4; ++j) a[j] = gelu_tanh((y0[j] + y1[j]) + d4[j] * u0[j]); \
                u32x2 w0; w0.x = pk_bf16(a[0], a[1]); w0.y = pk_bf16(a[2], a[3]); \
                *(u32x2*)(yo0 + (size_t)blk * 16 * D) = w0; \
            } \
            S5_BARRIER(); \
        } while (0)
        if (roleA) {
            for (int step = 0; step < nsteps; step += 4) { S5_A(step, an); S5_A(step + 1, an1); S5_A(step + 2, an2); S5_A(step + 3, an3); }
        } else {
            for (int step = 0; step < nsteps; step += 4) { S5_B(step, e3q); S5_B(step + 1, e0n); S5_B(step + 2, e1q); S5_B(step + 3, e2q); }
        }
#undef S5_A
#undef S5_B
#undef S5_BARRIER
        if (active && roleA) {
            const size_t si = ((size_t)(l * 8 + seqh) * 64 + g) * 64 + pst;
            float* ore = P.out + (prompt ? O_SRP : O_SRS); float* oim = P.out + (prompt ? O_SIP : O_SIS);
            ore[si] = hr; oim[si] = hi;
        }
    }
}

constexpr int LDS_TAB = 0, LDS_QS = 16512, LDS_S = LDS_QS + 4096, S_PITCH = 532;
constexpr float SCALE = 0.125f;

struct KVChunk { bf16x8 k[2][4]; u32x4 v[2][2][2]; };
DI void load_chunk(KVChunk& C, const bf16_t* kp, const bf16_t* vb0, const bf16_t* vb1) {
#pragma unroll
    for (int t = 0; t < 2; ++t) {
#pragma unroll
        for (int ks = 0; ks < 4; ++ks) C.k[t][ks] = *(const bf16x8*)(kp + (size_t)t * 32 * D + 16 * ks);
#pragma unroll
        for (int s = 0; s < 2; ++s) {
            C.v[t][0][s] = *(const u32x4*)(vb0 + t * 32 + 16 * s);
            C.v[t][1][s] = *(const u32x4*)(vb1 + t * 32 + 16 * s);
        }
    }
}
DI void attn_prompt_item(const Params& P, const float* tab  , int n, int c, int hd, int qh) {
    const int lane = otid() & 63, r = lane & 31, hh = lane >> 5;
    const bf16_t* QB = (const bf16_t*)(P.ws + OFF_QB);
    const bf16_t* KB = (const bf16_t*)(P.ws + OFF_KB);
    const bf16_t* VT = (const bf16_t*)(P.ws + OFF_VT);
    const int qrow = n * SEQ + c * 64 + qh * 32 + r;
    bf16x8 qf[4];
#pragma unroll
    for (int ks = 0; ks < 4; ++ks) qf[ks] = *(const bf16x8*)(QB + (size_t)qrow * D + hd * 64 + 16 * ks + 8 * hh);
    f32x16 o0, o1;
#pragma unroll
    for (int i = 0; i < 16; ++i) { o0[i] = 0.f; o1[i] = 0.f; }
    float m = -1e30f, lsum = 0.f;
    const float* trow = tab + hd * 257;
    const bf16_t* kbase = KB + (size_t)(n * SEQ + r) * D + hd * 64 + 8 * hh;
    const bf16_t* vbase0 = VT + ((size_t)(n * 16 + hd) * 64 + r) * SEQ + 8 * hh;
    const bf16_t* vbase1 = vbase0 + (size_t)32 * SEQ;
    const int kc0 = c > 8 ? c - 8 : 0;
    KVChunk A, B;
    load_chunk(A, kbase + (size_t)kc0 * 64 * D, vbase0 + kc0 * 64, vbase1 + kc0 * 64);
    for (int kc = kc0; kc <= c; ++kc) {
        if (kc < c) load_chunk(B, kbase + (size_t)(kc + 1) * 64 * D, vbase0 + (kc + 1) * 64, vbase1 + (kc + 1) * 64);
#pragma unroll
        for (int t = 0; t < 2; ++t) {
            const int kpos0 = kc * 64 + t * 32;
            f32x16 sa;
#pragma unroll
            for (int i = 0; i < 16; ++i) sa[i] = 0.f;
#pragma unroll
            for (int ks = 0; ks < 4; ++ks) sa = __builtin_amdgcn_mfma_f32_32x32x16_bf16(A.k[t][ks], qf[ks], sa, 0, 0, 0);
            const int dbase = (c * 64 + qh * 32 + r) - kpos0 - 4 * hh;
            const int dmin = (c * 64 + qh * 32) - kpos0 - 31;
            float sc[16]; float tmax = -1e30f;
            if (dmin >= 128) {
                const float bconst = trow[256];
#pragma unroll
                for (int i = 0; i < 16; ++i) { sc[i] = sa[i] * (SCALE * LOG2E) + bconst; tmax = fmaxf(tmax, sc[i]); }
            } else {
#pragma unroll
                for (int i = 0; i < 16; ++i) {
                    int rel = dbase - ((i & 3) + 8 * (i >> 2));
                    rel = rel < -128 ? -128 : (rel > 128 ? 128 : rel);
                    sc[i] = sa[i] * (SCALE * LOG2E) + trow[rel + 128]; tmax = fmaxf(tmax, sc[i]);
                }
            }
            tmax = fmaxf(tmax, __shfl_xor(tmax, 32));
            const float mn = fmaxf(m, tmax), alpha = fast_exp2(m - mn);
            const bool resc = __builtin_amdgcn_ballot_w64(mn > m) != 0ull;
            m = mn;
            float ps = 0.f;
#pragma unroll
            for (int i = 0; i < 16; ++i) { sc[i] = fast_exp2(sc[i] - mn); ps += sc[i]; }
            lsum = lsum * alpha + ps;
            if (resc) {
#pragma unroll
                for (int i = 0; i < 16; ++i) { o0[i] *= alpha; o1[i] *= alpha; }
            }
#pragma unroll
            for (int s = 0; s < 2; ++s) {
                u32x4 pw; pw.x = pk_bf16(sc[8 * s + 0], sc[8 * s + 1]); pw.y = pk_bf16(sc[8 * s + 2], sc[8 * s + 3]); pw.z = pk_bf16(sc[8 * s + 4], sc[8 * s + 5]); pw.w = pk_bf16(sc[8 * s + 6], sc[8 * s + 7]);
                const bf16x8 pf = __builtin_bit_cast(bf16x8, pw);
                o0 = __builtin_amdgcn_mfma_f32_32x32x16_bf16(__builtin_bit_cast(bf16x8, A.v[t][0][s]), pf, o0, 0, 0, 0);
                o1 = __builtin_amdgcn_mfma_f32_32x32x16_bf16(__builtin_bit_cast(bf16x8, A.v[t][1][s]), pf, o1, 0, 0, 0);
            }
        }
        A = B;
    }
    lsum += __shfl_xor(lsum, 32);
    const float inv = fast_rcp(lsum);
    bf16_t* op = (bf16_t*)(P.ws + OFF_XN) + (size_t)qrow * D + hd * 64 + 4 * hh;
#pragma unroll
    for (int g4 = 0; g4 < 4; ++g4) {
        u32x2 w; w.x = pk_bf16(o0[4 * g4] * inv, o0[4 * g4 + 1] * inv); w.y = pk_bf16(o0[4 * g4 + 2] * inv, o0[4 * g4 + 3] * inv);
        *(u32x2*)(op + 8 * g4) = w;
        u32x2 z; z.x = pk_bf16(o1[4 * g4] * inv, o1[4 * g4 + 1] * inv); z.y = pk_bf16(o1[4 * g4 + 2] * inv, o1[4 * g4 + 3] * inv);
        *(u32x2*)(op + 32 + 8 * g4) = z;
    }
}

struct KVTile { bf16x8 k[4]; u32x4 v[2][2]; };
DI void load_tile(KVTile& T, const bf16_t* kp, const bf16_t* vb0, const bf16_t* vb1) {
#pragma unroll
    for (int ks = 0; ks < 4; ++ks) T.k[ks] = *(const bf16x8*)(kp + 16 * ks);
#pragma unroll
    for (int s = 0; s < 2; ++s) { T.v[0][s] = *(const u32x4*)(vb0 + 16 * s); T.v[1][s] = *(const u32x4*)(vb1 + 16 * s); }
}
DI void attn_prompt_item64(const Params& P, const float* tab, int n, int c, int hd) {
    const int lane = otid() & 63, r = lane & 31, hh = lane >> 5;
    const bf16_t* QB = (const bf16_t*)(P.ws + OFF_QB);
    const bf16_t* KB = (const bf16_t*)(P.ws + OFF_KB);
    const bf16_t* VT = (const bf16_t*)(P.ws + OFF_VT);
    const int qrow = n * SEQ + c * 64 + r;
    bf16x8 qf[2][4];
#pragma unroll
    for (int qh = 0; qh < 2; ++qh)
#pragma unroll
        for (int ks = 0; ks < 4; ++ks) qf[qh][ks] = *(const bf16x8*)(QB + (size_t)(qrow + 32 * qh) * D + hd * 64 + 16 * ks + 8 * hh);
    f32x16 o[2][2];
#pragma unroll
    for (int i = 0; i < 16; ++i) { o[0][0][i] = 0.f; o[0][1][i] = 0.f; o[1][0][i] = 0.f; o[1][1][i] = 0.f; }
    float m[2] = {-1e30f, -1e30f}, lsum[2] = {0.f, 0.f};
    const float* trow = tab + hd * 257;
    const bf16_t* kbase = KB + (size_t)(n * SEQ + r) * D + hd * 64 + 8 * hh;
    const bf16_t* vbase0 = VT + ((size_t)(n * 16 + hd) * 64 + r) * SEQ + 8 * hh;
    const bf16_t* vbase1 = vbase0 + (size_t)32 * SEQ;
    const int kt0 = (c > 8 ? c - 8 : 0) * 2, kt1 = (c + 1) * 2;
    KVTile A, B;
    load_tile(A, kbase + (size_t)kt0 * 32 * D, vbase0 + kt0 * 32, vbase1 + kt0 * 32);
    for (int kt = kt0; kt < kt1; ++kt) {
        if (kt + 1 < kt1) load_tile(B, kbase + (size_t)(kt + 1) * 32 * D, vbase0 + (kt + 1) * 32, vbase1 + (kt + 1) * 32);
        const int kpos0 = kt * 32;
#pragma unroll
        for (int qh = 0; qh < 2; ++qh) {
            f32x16 sa;
#pragma unroll
            for (int i = 0; i < 16; ++i) sa[i] = 0.f;
#pragma unroll
            for (int ks = 0; ks < 4; ++ks) sa = __builtin_amdgcn_mfma_f32_32x32x16_bf16(A.k[ks], qf[qh][ks], sa, 0, 0, 0);
            const int dbase = (c * 64 + qh * 32 + r) - kpos0 - 4 * hh;
            const int dmin = (c * 64 + qh * 32) - kpos0 - 31;
            float sc[16]; float tmax = -1e30f;
            if (dmin >= 128) {
                const float bconst = trow[256];
#pragma unroll
                for (int i = 0; i < 16; ++i) { sc[i] = sa[i] * (SCALE * LOG2E) + bconst; tmax = fmaxf(tmax, sc[i]); }
            } else {
#pragma unroll
                for (int i = 0; i < 16; ++i) {
                    int rel = dbase - ((i & 3) + 8 * (i >> 2));
                    rel = rel < -128 ? -128 : (rel > 128 ? 128 : rel);
                    sc[i] = sa[i] * (SCALE * LOG2E) + trow[rel + 128]; tmax = fmaxf(tmax, sc[i]);
                }
            }
            tmax = fmaxf(tmax, __shfl_xor(tmax, 32));
            const float mn = fmaxf(m[qh], tmax), alpha = fast_exp2(m[qh] - mn);
            const bool resc = __builtin_amdgcn_ballot_w64(mn > m[qh]) != 0ull;
            m[qh] = mn;
            float ps = 0.f;
#pragma unroll
            for (int i = 0; i < 16; ++i) { sc[i] = fast_exp2(sc[i] - mn); ps += sc[i]; }
            lsum[qh] = lsum[qh] * alpha + ps;
            if (resc) {
#pragma unroll
                for (int i = 0; i < 16; ++i) { o[qh][0][i] *= alpha; o[qh][1][i] *= alpha; }
            }
#pragma unroll
            for (int s = 0; s < 2; ++s) {
                u32x4 pw; pw.x = pk_bf16(sc[8 * s + 0], sc[8 * s + 1]); pw.y = pk_bf16(sc[8 * s + 2], sc[8 * s + 3]); pw.z = pk_bf16(sc[8 * s + 4], sc[8 * s + 5]); pw.w = pk_bf16(sc[8 * s + 6], sc[8 * s + 7]);
                const bf16x8 pf = __builtin_bit_cast(bf16x8, pw);
                o[qh][0] = __builtin_amdgcn_mfma_f32_32x32x16_bf16(__builtin_bit_cast(bf16x8, A.v[0][s]), pf, o[qh][0], 0, 0, 0);
                o[qh][1] = __builtin_amdgcn_mfma_f32_32x32x16_bf16(__builtin_bit_cast(bf16x8, A.v[1][s]), pf, o[qh][1], 0, 0, 0);
            }
        }
        A = B;
    }
#pragma unroll
    for (int qh = 0; qh < 2; ++qh) {
        const float lt = lsum[qh] + __shfl_xor(lsum[qh], 32);
        const float inv = fast_rcp(lt);
        bf16_t* op = (bf16_t*)(P.ws + OFF_XN) + (size_t)(qrow + 32 * qh) * D + hd * 64 + 4 * hh;
#pragma unroll
        for (int g4 = 0; g4 < 4; ++g4) {
            u32x2 w; w.x = pk_bf16(o[qh][0][4 * g4] * inv, o[qh][0][4 * g4 + 1] * inv); w.y = pk_bf16(o[qh][0][4 * g4 + 2] * inv, o[qh][0][4 * g4 + 3] * inv);
            *(u32x2*)(op + 8 * g4) = w;
            u32x2 z; z.x = pk_bf16(o[qh][1][4 * g4] * inv, o[qh][1][4 * g4 + 1] * inv); z.y = pk_bf16(o[qh][1][4 * g4 + 2] * inv, o[qh][1][4 * g4 + 3] * inv);
            *(u32x2*)(op + 32 + 8 * g4) = z;
        }
    }
}

constexpr int LDS_RED = 57344;
DI void attn_sample_item(const Params& P, unsigned char* lds, int nb, int hd) {
    const int tid = otid(), wid = tid >> 6, lane = tid & 63;
    const float* tab = (const float*)(lds + LDS_TAB) + hd * 257;
    float* qs = (float*)(lds + LDS_QS);
    float* S = (float*)(lds + LDS_S);
    f32x2* red = (f32x2*)(lds + LDS_RED);
    const bf16_t* QB = (const bf16_t*)(P.ws + OFF_QB);
    for (int e = tid; e < 1024; e += 512) { const int qi = e >> 6, d = e & 63; qs[e] = __uint_as_float((unsigned)QB[(size_t)(NP + nb * 16 + qi) * D + hd * 64 + d] << 16) * (SCALE * LOG2E); }
    __syncthreads();
    for (int j = tid; j < 528; j += 512) {
        const float* kp = j < 512 ? P.in[4] + ((size_t)(nb * 512 + j) * 16 + hd) * 64 : P.out + O_KS + (size_t)(nb * 16 + (j - 512)) * D + hd * 64;
        float acc[16];
#pragma unroll
        for (int qi = 0; qi < 16; ++qi) acc[qi] = 0.f;
#pragma unroll 2
        for (int d4 = 0; d4 < 16; ++d4) {
            const f32x4 k4 = *(const f32x4*)(kp + 4 * d4);
#pragma unroll
            for (int qi = 0; qi < 16; ++qi) { const f32x4 q4 = *(const f32x4*)(qs + qi * 64 + 4 * d4); acc[qi] += k4[0] * q4[0] + k4[1] * q4[1] + k4[2] * q4[2] + k4[3] * q4[3]; }
        }
        const int kpos = j < 512 ? 3584 + j : 4096 + (j - 512);
#pragma unroll
        for (int qi = 0; qi < 16; ++qi) {
            int rel = (4096 + qi) - kpos; rel = rel < -128 ? -128 : (rel > 128 ? 128 : rel);
            S[qi * S_PITCH + j] = acc[qi] + tab[rel + 128];
        }
    }
    __syncthreads();
#pragma unroll
    for (int qq = 0; qq < 2; ++qq) {
        const int qi = wid * 2 + qq;
        float mx = -1e30f;
        for (int j = lane; j < 528; j += 64) mx = fmaxf(mx, S[qi * S_PITCH + j]);
        mx = wave_max(mx);
        float sm = 0.f;
        for (int j = lane; j < 528; j += 64) { const float e = fast_exp2(S[qi * S_PITCH + j] - mx); S[qi * S_PITCH + j] = e; sm += e; }
        sm = wave_sum(sm);
        const float inv = 1.0f / sm;
        for (int j = lane; j < 528; j += 64) S[qi * S_PITCH + j] *= inv;
    }
    __syncthreads();
    {
        const int sl = tid >> 5, l32 = tid & 31, dd = l32 * 2;
        f32x2 acc[16];
#pragma unroll
        for (int qi = 0; qi < 16; ++qi) acc[qi] = (f32x2){0.f, 0.f};
        const float* vc = P.in[5] + ((size_t)(nb * 512 + sl * 32) * 16 + hd) * 64 + dd;
#pragma unroll 8
        for (int jj = 0; jj < 32; ++jj) {
            const f32x2 v = *(const f32x2*)(vc + (size_t)jj * D);
#pragma unroll
            for (int qi = 0; qi < 16; ++qi) acc[qi] += v * S[qi * S_PITCH + sl * 32 + jj];
        }
        {
            const f32x2 v = *(const f32x2*)(P.out + O_VS + (size_t)(nb * 16 + sl) * D + hd * 64 + dd);
#pragma unroll
            for (int qi = 0; qi < 16; ++qi) acc[qi] += v * S[qi * S_PITCH + 512 + sl];
        }
#pragma unroll
        for (int qi = 0; qi < 16; ++qi) red[(sl * 16 + qi) * 32 + l32] = acc[qi];
    }
    __syncthreads();
    {
        const int qi = tid >> 5, l32 = tid & 31;
        f32x2 a = {0.f, 0.f};
#pragma unroll
        for (int sl = 0; sl < 16; ++sl) a += red[(sl * 16 + qi) * 32 + l32];
        *(unsigned*)((bf16_t*)(P.ws + OFF_XN) + (size_t)(NP + nb * 16 + qi) * D + hd * 64 + l32 * 2) = pk_bf16(a.x, a.y);
    }
    __syncthreads();
}

DI void attn_phase(const Params& P, unsigned char* lds, int b) {
    const int tid = otid(), wid = __builtin_amdgcn_readfirstlane(tid >> 6);
    float* tab = (float*)(lds + LDS_TAB);
    for (int e = tid; e < 16 * 257; e += 512) tab[e] = P.in[24][(size_t)b * 16 * 257 + e] * LOG2E;
    __syncthreads();
    if (ATTN_Q64) {
        for (int id = obid() * 8 + wid; id < 2048; id += (int)gridDim.x * 8) {
            const int hd = id & 15, cp = (id >> 4) & 15, n = id >> 8;
            attn_prompt_item64(P, tab, n, 31 - cp, hd);
            attn_prompt_item64(P, tab, n, cp, hd);
        }
        __syncthreads();
        if (gridDim.x == 256) { const int bid = obid(), cp = (bid >> 1) & 15; if (cp < 8) { const int it = (bid >> 5) * 16 + cp * 2 + (bid & 1); attn_sample_item(P, lds, it >> 4, it & 15); } }
        else { for (int it = (int)gridDim.x - 1 - obid(); it < 128; it += (int)gridDim.x) attn_sample_item(P, lds, it >> 4, it & 15); }
        return;
    }
    for (int it = (int)gridDim.x - 1 - obid(); it < 128; it += (int)gridDim.x) attn_sample_item(P, lds, it >> 4, it & 15);
    if (false) {
    } else if (ATTN_XCD_MAP && gridDim.x == 256) {
        const int bid = obid(), n = bid & 7, j = bid >> 3;
        for (int k = 0; k < 4; ++k) attn_prompt_item(P, tab, n, j, k * 4 + (wid >> 1), wid & 1);
    } else {
        for (int it = obid() * 8 + wid; it < 8192; it += (int)gridDim.x * 8) {
            const int qh = it & 1, hd = (it >> 1) & 15, n = it >> 10, c = (((it >> 5) & 31) + 8 * (n >> 1)) & 31;
            attn_prompt_item(P, tab, n, c, hd, qh);
        }
    }
}

#define XB_TMO      128
#define XB_XCNT(j)  (256  + 64 * (j))
#define XB_XSUB(j)  (1280 + 64 * (j))
#define XB_XGEN(j)  (2304 + 64 * (j))
#define XB_TOP      3328
#define XB_TOPGEN   3392
#define XCD_BAR_WORDS 3456
#define XB_SPIN_CAP (1u << 18)
DI unsigned xb_ld(unsigned* p)              { return __hip_atomic_load(p, __ATOMIC_RELAXED, __HIP_MEMORY_SCOPE_AGENT); }
DI unsigned xb_add(unsigned* p, unsigned v) { return __hip_atomic_fetch_add(p, v, __ATOMIC_RELAXED, __HIP_MEMORY_SCOPE_AGENT); }
DI unsigned xb_xcc_id() { return (unsigned)__builtin_amdgcn_s_getreg((3 << 11) | 20) & 0xFu; }
#define XB_SPIN(cond, bar) do { unsigned _sp = 0; while (cond) { __builtin_amdgcn_s_sleep(1); \
    if ((++_sp & 255u) == 0u) { if (xb_ld(&(bar)[XB_TMO])) break; if (_sp > XB_SPIN_CAP) { atomicAdd(&(bar)[XB_TMO], 1u); break; } } } } while (0)
struct XcdBarrier { unsigned* bar; unsigned x; volatile LAS unsigned* st; };
DI XcdBarrier xcd_barrier_post(unsigned* bar, volatile LAS unsigned* st) {
    XcdBarrier b; b.bar = bar; b.x = xb_xcc_id(); b.st = st;
    if (threadIdx.x == 0) (void)xb_add(&bar[XB_XCNT(b.x)], 1u);
    return b;
}
DI void xcd_barrier_complete(unsigned* bar, unsigned x, unsigned& nloc, unsigned& nx) {
    const unsigned G = gridDim.x * gridDim.y * gridDim.z;
    unsigned sum, cnt, mine, sp = 0u;
    for (;;) {
        sum = 0u; cnt = 0u; mine = 0u;
#pragma unroll
        for (unsigned j = 0; j < 16; ++j) { const unsigned c = xb_ld(&bar[XB_XCNT(j)]); sum += c; cnt += (c > 0u) ? 1u : 0u; mine = (j == x) ? c : mine; }
        if (sum == G) break;
        __builtin_amdgcn_s_sleep(1);
        if ((++sp & 255u) == 0u) { if (xb_ld(&bar[XB_TMO])) break; if (sp > XB_SPIN_CAP) { atomicAdd(&bar[XB_TMO], 1u); break; } }
    }
    nloc = mine > 0u ? mine : 1u; nx = cnt > 0u ? cnt : 1u;
}
DI void xcd_barrier(const XcdBarrier& b) {
    asm volatile("s_waitcnt vmcnt(0)" ::: "memory");
    __syncthreads();
    if (threadIdx.x == 0) {
        unsigned* bar = b.bar;
        __builtin_amdgcn_s_waitcnt(0);
        unsigned nloc = b.st[0], nx = b.st[1];
        if (nloc == 0u) { xcd_barrier_complete(bar, b.x, nloc, nx); b.st[0] = nloc; b.st[1] = nx; }
        const unsigned old = xb_add(&bar[XB_XSUB(b.x)], 1u);
        const unsigned gen = old / nloc;
        if (old + 1u == (gen + 1u) * nloc) {
            __builtin_amdgcn_fence(__ATOMIC_RELEASE, "agent");
            asm volatile("s_waitcnt vmcnt(0)" ::: "memory");
            const unsigned og = xb_add(&bar[XB_TOP], 1u);
            const unsigned tg = og / nx;
            if (og + 1u == (tg + 1u) * nx) xb_add(&bar[XB_TOPGEN], 1u);
            else XB_SPIN(xb_ld(&bar[XB_TOPGEN]) == tg, bar);
            __builtin_amdgcn_fence(__ATOMIC_ACQUIRE, "agent");
            xb_add(&bar[XB_XGEN(b.x)], 1u);
            asm volatile("s_waitcnt vmcnt(0)" ::: "memory");
        } else {
            XB_SPIN(xb_ld(&bar[XB_XGEN(b.x)]) == gen, bar);
            __builtin_amdgcn_fence(__ATOMIC_ACQUIRE, "agent");
            asm volatile("s_waitcnt vmcnt(0)" ::: "memory");
        }
    }
    __syncthreads();
}

__host__ __device__ inline bool phase_empty(int ph) {
    if (ph == 0) return false;
    const int L = (ph - 1) / 11, s = (ph - 1) % 11;
    if (s == 5 && L < 2) return true;
    if (s == 10 && L != 1) return true;
    return false;
}

template <class Epi>
DI void gemm_both(const Params& P, unsigned char* lds, const bf16_t* A, const bf16_t* Bt, int N, int K, const Epi& E, int defer_slot = -1) {
    pg8::Gemm g{A, Bt, NP, N, K}; pg8::StaticOrder S; S.init(NP, N, (int)gridDim.x, obid());
    pg8::gemm_phase<Epi>((LAS unsigned char*)lds, g, S, E);
    if (SMALL_ROWS && K == 1024) { const int rem = ((NP / 256) * (N / 256)) % (int)gridDim.x; small_gemm_rows<Epi>(A + (size_t)NP * K, Bt, N, K, E, rem); }
    else if (K == 1024) small_gemm3<Epi>(lds, A + (size_t)NP * K, Bt, N, E);
    else small_gemm<Epi>(lds, A + (size_t)NP * K, Bt, N, K, E);
    if (defer_slot >= 0) { const int rem = ((NP / 256) * (N / 256)) % (int)gridDim.x; __syncthreads(); convert_deferred(P, lds, defer_slot, rem); }
}

DI void run_phase(const Params& P, unsigned char* lds, int ph) {
    if (ph == 0) {
        convert_phase(P, lds);
        rowpass(P, nullptr, nullptr, 0.f, P.in[6], nullptr, true);
        return;
    }
    const int L = (ph - 1) / 11, s = (ph - 1) % 11;
    const float* gains = P.in[6] + (size_t)L * 6 * D;
    bf16_t* XN = (bf16_t*)(P.ws + OFF_XN);
    bf16_t* ACT = (bf16_t*)(P.ws + OFF_ACT);
    bf16_t* Y = (bf16_t*)(P.ws + OFF_Y);
    bf16_t* QB = (bf16_t*)(P.ws + OFF_QB);
    const bf16_t* WL = (const bf16_t*)(P.ws + (size_t)L * SZ_LAYER);
    switch (s) {
    case 0: { EpiSwiglu E{ACT}; gemm_both(P, lds, XN, WL, 5632, 1024, E, L < 2 ? L * 2 : (L == 2 ? 4 : -1)); } break;
    case 1: { EpiBf16 E{Y}; gemm_both(P, lds, ACT, WL + SZ_WIN / 2, 1024, 2816, E); } break;
    case 2: rowpass(P, Y, gains + 1 * D, 0.5f, gains + 2 * D, nullptr, false); break;
    case 3:
        if (L < 2) s5_phase(P, lds, L);
        else { EpiBf16 E{QB}; gemm_both(P, lds, XN, (const bf16_t*)(P.ws + OFF_WQ) + (size_t)(L - 2) * D * D, 1024, 1024, E); }
        break;
    case 4:
        if (L < 2) { EpiGlu E{Y}; gemm_both(P, lds, QB, (const bf16_t*)(P.ws + OFF_WGLU) + (size_t)L * 2048 * D, 2048, 1024, E); }
        else attn_phase(P, lds, L - 2);
        break;
    case 5: { EpiBf16 E{Y}; gemm_both(P, lds, XN, (const bf16_t*)(P.ws + OFF_WO) + (size_t)(L - 2) * D * D, 1024, 1024, E); } break;
    case 6: rowpass(P, Y, gains + 3 * D, 1.0f, gains + 4 * D, nullptr, false); break;
    case 7: { EpiSwiglu E{ACT}; gemm_both(P, lds, XN, WL + (SZ_WIN + SZ_WOUT) / 2, 5632, 1024, E, L < 2 ? L * 2 + 1 : (L == 2 ? 5 : -1)); } break;
    case 8: { EpiBf16 E{Y}; gemm_both(P, lds, ACT, WL + (2 * SZ_WIN + SZ_WOUT) / 2, 1024, 2816, E); } break;
    case 9: rowpass(P, Y, gains + 5 * D, 0.5f, L < 3 ? gains + 6 * D : nullptr, L == 1 ? P.in[20] : nullptr, false); break;
    case 10: { EpiKV E{(bf16_t*)(P.ws + OFF_KB), (bf16_t*)(P.ws + OFF_VT), P.out}; gemm_both(P, lds, QB, (const bf16_t*)(P.ws + OFF_WKV), 2048, 1024, E); } break;
    }
}

__global__ void __launch_bounds__(512, 2) yoco_fwd(Params P) {
    extern __shared__ __attribute__((aligned(16))) unsigned char lds[];
    volatile LAS unsigned* st = (volatile LAS unsigned*)((LAS unsigned char*)lds + 131072);
    if (threadIdx.x < 4) st[threadIdx.x] = 0u;
    __syncthreads();
    const bool multi = P.ph_hi - P.ph_lo > 1;
    XcdBarrier bar; bar.bar = (unsigned*)(P.ws + OFF_BAR); bar.x = 0; bar.st = st;
    if (multi) bar = xcd_barrier_post((unsigned*)(P.ws + OFF_BAR), st);
    if (P.ph_lo < 0) cg::this_grid().sync();
#define GRID_SYNC() xcd_barrier(bar)
    for (int ph = P.ph_lo; ph < P.ph_hi; ++ph) {
        if (phase_empty(ph)) continue;
        Params Q = P;
        { size_t z = 0; asm volatile("" : "+s"(z)); Q.ws = P.ws + z; Q.out = P.out + z; }
        run_phase(Q, lds, ph);
        if (REPEAT_MASK) { const int kind = ph == 0 ? 11 : (ph - 1) % 11; if ((REPEAT_MASK >> kind) & 1) { GRID_SYNC(); run_phase(Q, lds, ph); } }
        for (int e = 0; e < EXTRA_SYNCS; ++e) GRID_SYNC();
        if (ph + 1 < P.ph_hi) GRID_SYNC();
    }
}

extern "C" void kernel_launch(void* const* d_in, const int* in_sizes, int n_in, void* d_out, int out_size, void* d_ws, size_t ws_size, hipStream_t stream) {
    static int grid = 0;
    if (grid == 0) {
        int dev = 0, cus = 0, per_cu = 0;
        hipGetDevice(&dev);
        hipDeviceGetAttribute(&cus, hipDeviceAttributeMultiprocessorCount, dev);
        if (hipFuncSetAttribute((const void*)yoco_fwd, hipFuncAttributeMaxDynamicSharedMemorySize, LDS_BYTES) != hipSuccess) { fprintf(stderr, "hipFuncSetAttribute failed\n"); grid = -1; return; }
        hipOccupancyMaxActiveBlocksPerMultiprocessor(&per_cu, (const void*)yoco_fwd, 512, LDS_BYTES);
        if (per_cu < 1) per_cu = 1;
        grid = cus * per_cu;
        if (n_in != 25 || ws_size < WS_END) { fprintf(stderr, "bad n_in %d or ws %zu < %zu\n", n_in, ws_size, (size_t)WS_END); grid = -1; return; }
    }
    if (grid < 0) return;
    Params p{};
    for (int i = 0; i < 25; ++i) p.in[i] = (const float*)d_in[i];
    p.out = (float*)d_out; p.ws = (unsigned char*)d_ws;
#if MEGA
    hipMemsetAsync((char*)d_ws + OFF_BAR, 0, 16384, stream);
    p.ph_lo = 0; p.ph_hi = N_PHASES;
    void* args[] = {&p};
    hipError_t e = hipLaunchCooperativeKernel((const void*)yoco_fwd, dim3(grid), dim3(512), args, LDS_BYTES, stream);
    if (e != hipSuccess) fprintf(stderr, "cooperative launch failed: %s (grid %d)\n", hipGetErrorString(e), grid);
#else
    for (int ph = 0; ph < N_PHASES; ++ph) {
        if (phase_empty(ph)) continue;
        p.ph_lo = ph; p.ph_hi = ph + 1;
        hipLaunchKernelGGL(yoco_fwd, dim3(grid), dim3(512), LDS_BYTES, stream, p);
    }
#endif
}
```
